# Optimizing an MI355X kernel written in HIP

```python
import math
import jax, jax.numpy as jnp
from jax import lax
import numpy as np

D_MODEL = 1024
BATCH = 8
SEQ = 4096
DEPTH = 2

GRID_W = 64
CTX_LEN = 256
ROPE_BASE = 10000.0
EPS = 1e-6
NEG_INF = -1e30

A_HEADS = 8
A_KV_HEADS = 2
A_GROUP = A_HEADS // A_KV_HEADS
A_HEAD_DIM = 64
A_WIDTH = A_HEADS * A_HEAD_DIM
WINDOW = 128

B_HEADS = 8
B_NOPE = 64
B_ROPE = 32
B_VDIM = 64
B_WIDTH = B_HEADS * B_VDIM
Q_LORA = 256
KV_LORA = 256
Q_BLOCK = 128

POOL_WINDOWS = (2, 4, 8, 16)
C_GROUPS = 4
C_GROUP_DIM = 128
C_WIDTH = C_GROUPS * C_GROUP_DIM

N_BRANCH = 3
IN_SPLITS = (A_WIDTH, A_KV_HEADS * A_HEAD_DIM, A_KV_HEADS * A_HEAD_DIM,
             Q_LORA, KV_LORA, B_ROPE, C_WIDTH, N_BRANCH * D_MODEL)
IN_WIDTH = sum(IN_SPLITS)

N_GROUPS = 4
EXPERTS_PER_GROUP = 8
N_EXPERTS = N_GROUPS * EXPERTS_PER_GROUP
TOP_K = 2
EXPERT_FF = 256
EXPERT_BLOCK = 128

kernel_name = 'hybrid_gated_swa_mla_pool_hmoe_dit'


def rmsnorm(x, g):
    xf = x.astype(jnp.float32)
    y = xf * lax.rsqrt(jnp.mean(xf * xf, axis=-1, keepdims=True) + EPS)
    return (y * g.astype(jnp.float32)).astype(x.dtype)


def modulate(h, g, shift, scale):
    return rmsnorm(h, g) * (1 + scale) + shift


def axial_rope_tables(rows, rot_dim):
    row = jnp.repeat(jnp.arange(rows), GRID_W).astype(jnp.float32)
    col = jnp.tile(jnp.arange(GRID_W), rows).astype(jnp.float32)
    axis_dim = rot_dim // 2
    inv = ROPE_BASE ** (-jnp.arange(0, axis_dim, 2, dtype=jnp.float32) / axis_dim)
    ang = jnp.concatenate([row[:, None] * inv, col[:, None] * inv], axis=-1)
    return jnp.cos(ang), jnp.sin(ang)


def apply_rope(x, cos, sin):
    xf = x.astype(jnp.float32)
    x1, x2 = xf[..., 0::2], xf[..., 1::2]
    c, s = cos[:, None, :], sin[:, None, :]
    out = jnp.stack([x1 * c - x2 * s, x1 * s + x2 * c], axis=-1).reshape(x.shape)
    return out.astype(x.dtype)


def split_in(p):
    idx, acc = [], 0
    for w in IN_SPLITS[:-1]:
        acc += w
        idx.append(acc)
    return jnp.split(p, idx, axis=-1)


def window_attn(q, k, v, kc, vc, sink):
    B, N = q.shape[:2]
    nb = N // WINDOW
    scale = A_HEAD_DIM ** -0.5
    qb = q.reshape(B, nb, WINDOW, A_KV_HEADS, A_GROUP, A_HEAD_DIM)
    pad = ((0, 0), (WINDOW, WINDOW), (0, 0), (0, 0))
    kp = jnp.pad(k, pad).reshape(B, nb + 2, WINDOW, A_KV_HEADS, A_HEAD_DIM)
    vp = jnp.pad(v, pad).reshape(B, nb + 2, WINDOW, A_KV_HEADS, A_HEAD_DIM)
    kband = jnp.concatenate([kp[:, :-2], kp[:, 1:-1], kp[:, 2:]], axis=2)
    vband = jnp.concatenate([vp[:, :-2], vp[:, 1:-1], vp[:, 2:]], axis=2)
    s_loc = jnp.einsum('bnqhgd,bnkhd->bnhgqk', qb, kband).astype(jnp.float32) * scale
    s_ctx = jnp.einsum('bnqhgd,bchd->bnhgqc', qb, kc).astype(jnp.float32) * scale
    rel = jnp.arange(3 * WINDOW)[None, :] - WINDOW - jnp.arange(WINDOW)[:, None]
    band = jnp.abs(rel) <= WINDOW
    kpos = jnp.arange(nb)[:, None] * WINDOW - WINDOW + jnp.arange(3 * WINDOW)[None, :]
    valid = (kpos >= 0) & (kpos < N)
    mask = band[None, :, :] & valid[:, None, :]
    s_loc = jnp.where(mask[None, :, None, None, :, :], s_loc, NEG_INF)
    sk = jnp.broadcast_to(sink.astype(jnp.float32).reshape(A_KV_HEADS, A_GROUP)[None, None, :, :, None, None],
                          s_loc.shape[:-1] + (1,))
    p = jax.nn.softmax(jnp.concatenate([s_loc, s_ctx, sk], axis=-1), axis=-1)
    p_loc = p[..., :3 * WINDOW].astype(v.dtype)
    p_ctx = p[..., 3 * WINDOW:3 * WINDOW + kc.shape[1]].astype(v.dtype)
    o = (jnp.einsum('bnhgqk,bnkhd->bnqhgd', p_loc, vband)
         + jnp.einsum('bnhgqc,bchd->bnqhgd', p_ctx, vc))
    return o.reshape(B, N, A_WIDTH)


def ctx_gqa_attn(q, k, v, sink):
    B, L = q.shape[:2]
    qg = q.reshape(B, L, A_KV_HEADS, A_GROUP, A_HEAD_DIM)
    s = jnp.einsum('bqhgd,bkhd->bhgqk', qg, k).astype(jnp.float32) * (A_HEAD_DIM ** -0.5)
    sk = jnp.broadcast_to(sink.astype(jnp.float32).reshape(A_KV_HEADS, A_GROUP)[None, :, :, None, None],
                          s.shape[:-1] + (1,))
    p = jax.nn.softmax(jnp.concatenate([s, sk], axis=-1), axis=-1)[..., :-1].astype(v.dtype)
    o = jnp.einsum('bhgqk,bkhd->bqhgd', p, v)
    return o.reshape(B, L, A_WIDTH)


def mla_qkv(cq, ckv, kr, q_norm_g, w_uq, kv_norm_g, w_ukv, rope):
    B, L, _ = cq.shape
    q = (rmsnorm(cq, q_norm_g) @ w_uq).reshape(B, L, B_HEADS, B_NOPE + B_ROPE)
    kv = (rmsnorm(ckv, kv_norm_g) @ w_ukv).reshape(B, L, B_HEADS, B_NOPE + B_VDIM)
    q_nope, q_rope = q[..., :B_NOPE], q[..., B_NOPE:]
    k_nope, v = kv[..., :B_NOPE], kv[..., B_NOPE:]
    k_rope = kr[:, :, None, :]
    if rope is not None:
        q_rope = apply_rope(q_rope, *rope)
        k_rope = apply_rope(k_rope, *rope)
    q = jnp.concatenate([q_nope, q_rope], axis=-1)
    k = jnp.concatenate([k_nope, jnp.broadcast_to(k_rope, (B, L, B_HEADS, B_ROPE))], axis=-1)
    return q, k, v


def dense_attn(q, k, v):
    s = jnp.einsum('bqhd,bkhd->bhqk', q, k).astype(jnp.float32) * (q.shape[-1] ** -0.5)
    p = jax.nn.softmax(s, axis=-1).astype(v.dtype)
    o = jnp.einsum('bhqk,bkhd->bqhd', p, v)
    return o.reshape(q.shape[0], q.shape[1], -1)


def blocked_dense_attn(q, k, v):
    B, N, H, dq = q.shape
    nb = N // Q_BLOCK
    qb = q.reshape(B, nb, Q_BLOCK, H, dq).transpose(1, 0, 2, 3, 4)
    o = lax.map(lambda qblk: dense_attn(qblk, k, v), qb)
    return o.transpose(1, 0, 2, 3).reshape(B, N, -1)


def pool_mixer(u, w_pool, pool_scale):
    B, L, _ = u.shape
    uf = u.astype(jnp.float32)
    cs = jnp.concatenate([jnp.zeros((B, 1, C_WIDTH), jnp.float32), jnp.cumsum(uf, axis=1)], axis=1)
    t = jnp.arange(L)
    parts = []
    for g, w in enumerate(POOL_WINDOWS):
        r = w // 2
        lo = jnp.maximum(t - r, 0)
        hi = jnp.minimum(t + r + 1, L)
        sl = slice(g * C_GROUP_DIM, (g + 1) * C_GROUP_DIM)
        win_sum = cs[:, hi, sl] - cs[:, lo, sl]
        parts.append(win_sum / (hi - lo).astype(jnp.float32)[:, None] - uf[:, :, sl])
    pooled = jnp.concatenate(parts, axis=-1).reshape(B, L, C_GROUPS, C_GROUP_DIM).astype(u.dtype)
    mixed = jnp.einsum('blgc,gcd->blgd', pooled, w_pool).reshape(B, L, C_WIDTH)
    return mixed * pool_scale


def merge_branches(gates, oa, ob, oc, lp):
    ga, gb, gc = jnp.split(gates, N_BRANCH, axis=-1)
    y = (jax.nn.sigmoid(ga) * (oa @ lp['w_br_a'])
         + jax.nn.sigmoid(gb) * (ob @ lp['w_br_b'])
         + jax.nn.sigmoid(gc) * (oc @ lp['w_br_c']))
    return y @ lp['w_out']


def mixer_block(hx, hc, lp, rope_a, rope_b, last):
    B, N, _ = hx.shape
    Lc = hc.shape[1]
    qa, ka, va, cq, ckv, kr, u, gates = split_in(hx @ lp['w_in'])
    qa_c, ka_c, va_c, cq_c, ckv_c, kr_c, u_c, gates_c = split_in(hc @ lp['w_in'])
    qa = apply_rope(qa.reshape(B, N, A_HEADS, A_HEAD_DIM), *rope_a)
    ka = apply_rope(ka.reshape(B, N, A_KV_HEADS, A_HEAD_DIM), *rope_a)
    va = va.reshape(B, N, A_KV_HEADS, A_HEAD_DIM)
    ka_c = ka_c.reshape(B, Lc, A_KV_HEADS, A_HEAD_DIM)
    va_c = va_c.reshape(B, Lc, A_KV_HEADS, A_HEAD_DIM)
    oa = window_attn(qa, ka, va, ka_c, va_c, lp['sink'])
    qb, kb, vb = mla_qkv(cq, ckv, kr, lp['q_norm_g'], lp['w_uq'], lp['kv_norm_g'], lp['w_ukv'], rope_b)
    qb_c, kb_c, vb_c = mla_qkv(cq_c, ckv_c, kr_c, lp['q_norm_g'], lp['w_uq'], lp['kv_norm_g'], lp['w_ukv'], None)
    ob = blocked_dense_attn(qb, jnp.concatenate([kb_c, kb], axis=1), jnp.concatenate([vb_c, vb], axis=1))
    oc = pool_mixer(u, lp['w_pool'], lp['pool_scale'])
    out_x = merge_branches(gates, oa, ob, oc, lp)
    if last:
        return out_x, None
    oa_c = ctx_gqa_attn(qa_c.reshape(B, Lc, A_HEADS, A_HEAD_DIM), ka_c, va_c, lp['sink'])
    ob_c = dense_attn(qb_c, kb_c, vb_c)
    oc_c = pool_mixer(u_c, lp['w_pool'], lp['pool_scale'])
    out_c = merge_branches(gates_c, oa_c, ob_c, oc_c, lp)
    return out_x, out_c


def hier_moe(h, w_rg, b_rg, w_re, b_re, w_gu, w_dn):
    T, D = h.shape
    g_logits = (h @ w_rg + b_rg).astype(jnp.float32)
    e_logits = (h @ w_re + b_re).astype(jnp.float32).reshape(T, N_GROUPS, EXPERTS_PER_GROUP)
    g_sel = jnp.argmax(g_logits, axis=-1)
    g_p = jnp.take_along_axis(jax.nn.softmax(g_logits, axis=-1), g_sel[:, None], axis=1)
    e_grp = jnp.take_along_axis(e_logits, g_sel[:, None, None], axis=1)[:, 0]
    top_v, top_i = lax.top_k(e_grp, TOP_K)
    gate = jax.nn.softmax(top_v, axis=-1) * g_p
    expert = g_sel[:, None] * EXPERTS_PER_GROUP + top_i
    A = T * TOP_K
    flat_e = expert.reshape(A)
    order = jnp.argsort(flat_e)
    e_sorted = flat_e[order]
    tok_sorted = order // TOP_K
    gate_sorted = gate.reshape(A)[order]
    counts = jax.ops.segment_sum(jnp.ones((A,), jnp.int32), flat_e, num_segments=N_EXPERTS)
    padded = (counts + EXPERT_BLOCK - 1) // EXPERT_BLOCK * EXPERT_BLOCK
    pad_end = jnp.cumsum(padded)
    pad_start = pad_end - padded
    start = jnp.cumsum(counts) - counts
    slot = pad_start[e_sorted] + (jnp.arange(A) - start[e_sorted])
    n_blocks = -(-(A + N_EXPERTS * (EXPERT_BLOCK - 1)) // EXPERT_BLOCK)
    P = n_blocks * EXPERT_BLOCK
    buf = jnp.zeros((P, D), h.dtype).at[slot].set(h[tok_sorted])
    blk_e = jnp.minimum(jnp.searchsorted(pad_end, jnp.arange(n_blocks) * EXPERT_BLOCK, side='right'),
                        N_EXPERTS - 1)

    def run_block(args):
        xb, e = args
        gt, up = jnp.split(xb @ w_gu[e], 2, axis=-1)
        return (jax.nn.silu(gt) * up) @ w_dn[e]

    yb = lax.map(run_block, (buf.reshape(n_blocks, EXPERT_BLOCK, D), blk_e))
    y = yb.reshape(P, D)[slot] * gate_sorted[:, None].astype(h.dtype)
    return jax.ops.segment_sum(y, tok_sorted, num_segments=T)


def setup_inputs(seed: int = 0) -> dict:
    key = jax.random.key(seed)
    ks = jax.random.split(key, 32)
    nrm = jax.random.normal
    f32 = jnp.float32
    D = D_MODEL
    return {
        'x': nrm(ks[0], (BATCH, SEQ, D), f32),
        'c': nrm(ks[1], (BATCH, D), f32),
        'ctx': nrm(ks[2], (BATCH, CTX_LEN, D), f32),
        'c_ctx': nrm(ks[3], (D,), f32),
        'w_mod': nrm(ks[4], (DEPTH, D, 6 * D), f32) * (0.5 * D ** -0.5),
        'b_mod': nrm(ks[5], (DEPTH, 6 * D), f32) * 0.01,
        'norm_mix_g': 1.0 + 0.02 * nrm(ks[6], (DEPTH, D), f32),
        'norm_ffn_g': 1.0 + 0.02 * nrm(ks[7], (DEPTH, D), f32),
        'w_in': nrm(ks[8], (DEPTH, D, IN_WIDTH), f32) * D ** -0.5,
        'sink': 0.5 * nrm(ks[9], (DEPTH, A_HEADS), f32),
        'q_norm_g': 1.0 + 0.02 * nrm(ks[10], (DEPTH, Q_LORA), f32),
        'w_uq': nrm(ks[11], (DEPTH, Q_LORA, B_HEADS * (B_NOPE + B_ROPE)), f32) * Q_LORA ** -0.5,
        'kv_norm_g': 1.0 + 0.02 * nrm(ks[12], (DEPTH, KV_LORA), f32),
        'w_ukv': nrm(ks[13], (DEPTH, KV_LORA, B_HEADS * (B_NOPE + B_VDIM)), f32) * KV_LORA ** -0.5,
        'w_pool': nrm(ks[14], (DEPTH, C_GROUPS, C_GROUP_DIM, C_GROUP_DIM), f32) * C_GROUP_DIM ** -0.5,
        'pool_scale': 1.0 + 0.02 * nrm(ks[15], (DEPTH, C_WIDTH), f32),
        'w_br_a': nrm(ks[16], (DEPTH, A_WIDTH, D), f32) * A_WIDTH ** -0.5,
        'w_br_b': nrm(ks[17], (DEPTH, B_WIDTH, D), f32) * B_WIDTH ** -0.5,
        'w_br_c': nrm(ks[18], (DEPTH, C_WIDTH, D), f32) * C_WIDTH ** -0.5,
        'w_out': nrm(ks[19], (DEPTH, D, D), f32) * D ** -0.5,
        'w_rg': nrm(ks[20], (DEPTH, D, N_GROUPS), f32) * D ** -0.5,
        'b_rg': 0.01 * nrm(ks[21], (DEPTH, N_GROUPS), f32),
        'w_re': nrm(ks[22], (DEPTH, D, N_EXPERTS), f32) * D ** -0.5,
        'b_re': 0.01 * nrm(ks[23], (DEPTH, N_EXPERTS), f32),
        'w_gu': nrm(ks[24], (DEPTH, N_EXPERTS, D, 2 * EXPERT_FF), f32) * D ** -0.5,
        'w_dn': nrm(ks[25], (DEPTH, N_EXPERTS, EXPERT_FF, D), f32) * EXPERT_FF ** -0.5,
        'final_g': 1.0 + 0.02 * nrm(ks[26], (D,), f32),
    }


def reference(x, c, ctx, c_ctx, w_mod, b_mod, norm_mix_g, norm_ffn_g, w_in, sink, q_norm_g, w_uq,
              kv_norm_g, w_ukv, w_pool, pool_scale, w_br_a, w_br_b, w_br_c, w_out, w_rg, b_rg, w_re,
              b_re, w_gu, w_dn, final_g):
    B, N, D = x.shape
    Lc = ctx.shape[1]
    ROWS = N // GRID_W
    rope_a = axial_rope_tables(ROWS, A_HEAD_DIM)
    rope_b = axial_rope_tables(ROWS, B_ROPE)
    h, hcs = x, ctx
    for l in range(DEPTH):
        last = l == DEPTH - 1
        lp = {'w_in': w_in[l], 'sink': sink[l], 'q_norm_g': q_norm_g[l], 'w_uq': w_uq[l],
              'kv_norm_g': kv_norm_g[l], 'w_ukv': w_ukv[l], 'w_pool': w_pool[l],
              'pool_scale': pool_scale[l], 'w_br_a': w_br_a[l], 'w_br_b': w_br_b[l],
              'w_br_c': w_br_c[l], 'w_out': w_out[l]}
        mod_x = jax.nn.silu(c) @ w_mod[l] + b_mod[l]
        mod_c = (jax.nn.silu(c_ctx) @ w_mod[l] + b_mod[l])[None]
        sh1, sc1, g1, sh2, sc2, g2 = jnp.split(mod_x[:, None, :], 6, axis=-1)
        sh1c, sc1c, g1c, sh2c, sc2c, g2c = jnp.split(mod_c[:, None, :], 6, axis=-1)
        hx = modulate(h, norm_mix_g[l], sh1, sc1)
        hc = modulate(hcs, norm_mix_g[l], sh1c, sc1c)
        mix_x, mix_c = mixer_block(hx, hc, lp, rope_a, rope_b, last)
        h = h + g1 * mix_x
        fx = modulate(h, norm_ffn_g[l], sh2, sc2).reshape(B * N, D)
        if last:
            ffn = hier_moe(fx, w_rg[l], b_rg[l], w_re[l], b_re[l], w_gu[l], w_dn[l])
            h = h + g2 * ffn.reshape(B, N, D)
        else:
            hcs = hcs + g1c * mix_c
            fc = modulate(hcs, norm_ffn_g[l], sh2c, sc2c).reshape(B * Lc, D)
            ffn = hier_moe(jnp.concatenate([fx, fc], axis=0), w_rg[l], b_rg[l], w_re[l], b_re[l],
                           w_gu[l], w_dn[l])
            h = h + g2 * ffn[:B * N].reshape(B, N, D)
            hcs = hcs + g2c * ffn[B * N:].reshape(B, Lc, D)
    return rmsnorm(h, final_g)
```

```cpp
#include <hip/hip_runtime.h>
#include <hip/hip_cooperative_groups.h>
#include <cstdio>
#include <cstdint>
namespace cg = cooperative_groups;

#ifndef MK_ONE_LAUNCH
#define MK_ONE_LAUNCH 1
#endif

#define DEV __device__ __forceinline__
typedef unsigned short bf16_t;
typedef unsigned u32x4 __attribute__((ext_vector_type(4)));
typedef unsigned u32x2 __attribute__((ext_vector_type(2)));
typedef float f32x4 __attribute__((ext_vector_type(4)));

constexpr int DM = 1024, NB = 8, SEQ = 4096, LC = 256, DEPTH = 2;
constexpr int RX = NB * SEQ, RC = NB * LC, R = RX + RC;
constexpr int NIN = 5120;
constexpr int NEXP = 32, EFF = 256;
constexpr int MAXTILES = 304;
constexpr float EPS = 1e-6f;
constexpr float LOG2E = 1.4426950408889634f;
constexpr float SCALE_A = 0.125f * LOG2E;
constexpr float SCALE_B = 0.10206207261596577f * LOG2E;

constexpr int C_QA = 0, C_KA = 512, C_VA = 640, C_CQ = 768, C_CKV = 1024, C_U = 1280, C_G = 1792, C_KR = 4864, C_END = 4896;

constexpr size_t MiB = 1ull << 20;
constexpr size_t WS_MOD = 0;
constexpr size_t WS_TABA = 448 * 1024;
constexpr size_t WS_TABB = 460 * 1024;
constexpr size_t WS_CNT = 512 * 1024;
constexpr size_t WS_WRE = 1 * MiB;
constexpr size_t WS_BAR = 576 * 1024;
constexpr size_t WS_SSQ = 6 * MiB + 512 * 1024;
constexpr size_t WS_GATE = 1 * MiB + 512 * 1024;
constexpr size_t WS_LIST = 2 * MiB;
constexpr size_t WS_W = 8 * MiB;
constexpr size_t WS_W1 = 140 * MiB;
constexpr size_t W_IN = 0, W_UQ = W_IN + (size_t)NIN * 1024 * 2, W_UKV = W_UQ + 768 * 256 * 2, W_BA = W_UKV + 1024 * 256 * 2,
                 W_BB = W_BA + 1024 * 512 * 2, W_BC = W_BB + 1024 * 512 * 2, W_OUT = W_BC + 1024 * 512 * 2,
                 W_GU = W_OUT + 1024 * 1024 * 2, W_DN = W_GU + (size_t)NEXP * 512 * 1024 * 2, W_TOTAL = W_DN + (size_t)NEXP * 1024 * 256 * 2;
static_assert(W_TOTAL <= 64 * MiB, "weights");
constexpr size_t WS_H = 72 * MiB;
constexpr size_t WS_XN = 208 * MiB;
constexpr size_t WS_QA = 276 * MiB;
constexpr size_t WS_QB = 310 * MiB;
constexpr size_t WS_KNB = 361 * MiB;
constexpr size_t WS_VB = 395 * MiB;
constexpr size_t WS_CQ = 429 * MiB;
constexpr size_t WS_CKV = 446 * MiB;
constexpr size_t WS_POOL = 429 * MiB;
constexpr size_t WS_U = 463 * MiB;
constexpr size_t WS_YTOK = 310 * MiB;
constexpr size_t WS_H1 = 446 * MiB;
constexpr size_t WS_Y = 361 * MiB;
constexpr size_t WS_FX = 361 * MiB;
constexpr size_t WS_NEED = 512 * MiB;
constexpr size_t DO_G = 0;
constexpr size_t DO_KA = (size_t)R * 3072;
constexpr size_t DO_VA = DO_KA + (size_t)R * 128 * 2;
constexpr size_t DO_KR = DO_VA + (size_t)R * 128 * 2;
constexpr size_t DO_SSQH = DO_KR + (size_t)R * 32 * 2;
constexpr size_t DO_LGATE = DO_SSQH + (size_t)R * 16 * 4;
static_assert(DO_LGATE + (size_t)NEXP * R * 4 <= (size_t)RX * DM * 4, "d_out scratch");

struct Params { const float* in[27]; float* out; unsigned char* ws; int ph_lo, ph_hi; };
enum { I_X = 0, I_C, I_CTX, I_CCTX, I_WMOD, I_BMOD, I_GMIX, I_GFFN, I_WIN, I_SINK, I_QNG, I_WUQ, I_KVNG, I_WUKV, I_WPOOL, I_PSCALE,
       I_WBA, I_WBB, I_WBC, I_WOUT, I_WRG, I_BRG, I_WRE, I_BRE, I_WGU, I_WDN, I_FING };

DEV float bf2f(bf16_t v) { return __uint_as_float((unsigned)v << 16); }
DEV unsigned f2bf(float f) { unsigned u = __float_as_uint(f); return (u + 0x7fffu + ((u >> 16) & 1u)) >> 16; }
DEV unsigned pk2(float lo, float hi) { unsigned r; asm("v_cvt_pk_bf16_f32 %0, %1, %2" : "=v"(r) : "v"(lo), "v"(hi)); return r; }
DEV void unpack8(const u32x4 w, float (&f)[8]) {
    f[0] = __uint_as_float(w.x << 16); f[1] = __uint_as_float(w.x & 0xffff0000u); f[2] = __uint_as_float(w.y << 16); f[3] = __uint_as_float(w.y & 0xffff0000u);
    f[4] = __uint_as_float(w.z << 16); f[5] = __uint_as_float(w.z & 0xffff0000u); f[6] = __uint_as_float(w.w << 16); f[7] = __uint_as_float(w.w & 0xffff0000u);
}
DEV u32x4 pack8(const float (&f)[8]) { u32x4 w; w.x = pk2(f[0], f[1]); w.y = pk2(f[2], f[3]); w.z = pk2(f[4], f[5]); w.w = pk2(f[6], f[7]); return w; }
DEV float wave_sum(float v) {
#pragma unroll
    for (int o = 1; o < 64; o <<= 1) v += __shfl_xor(v, o);
    return v;
}
DEV float sigmoidf_(float x) { return 1.f / (1.f + __expf(-x)); }
DEV float sigmoid_fast(float x) { return __builtin_amdgcn_rcpf(1.f + __builtin_amdgcn_exp2f(x * (-LOG2E))); }
DEV int mod_idx(int row) { return row < RX ? (row >> 12) : 8; }
DEV const float* modp(const unsigned char* ws, int l, int mb, int chunk) { return (const float*)(ws + WS_MOD) + ((size_t)(l * 9 + mb) * 6 + chunk) * 1024; }

struct Ctx {
    const Params* p; unsigned char* ws; unsigned char* dout; unsigned char* lds; int z; int dummy; size_t wofs, wre;
    int tid, lane, wave, G, gw, NGW, gtid, NT;
};

DEV void epi_inproj(const Ctx& c, int row, int col0, const float (&vin)[8], const f32x4 (&tb)[2]) {
    float v[8];
#pragma unroll
    for (int i = 0; i < 8; ++i) v[i] = vin[i];
    const bool xrow = row < RX;
    if (col0 < C_VA) {
        const bool isq = col0 < C_KA;
        const int w0 = col0 & 63;
        if (xrow) {
#pragma unroll
            for (int i = 0; i < 4; ++i) { const float cx = tb[i >> 1][2 * (i & 1)], sx = tb[i >> 1][2 * (i & 1) + 1]; const float a = v[2 * i], b = v[2 * i + 1]; v[2 * i] = a * cx - b * sx; v[2 * i + 1] = a * sx + b * cx; }
        }
        if (isq) {
#pragma unroll
            for (int i = 0; i < 8; ++i) v[i] *= SCALE_A;
            *(u32x4*)((bf16_t*)(c.ws + WS_QA) + (size_t)row * 512 + col0) = pack8(v);
        } else *(u32x4*)((bf16_t*)(c.dout + DO_KA) + (size_t)row * 128 + (col0 - C_KA)) = pack8(v);
    } else if (col0 < C_CQ) {
        *(u32x4*)((bf16_t*)(c.dout + DO_VA) + (size_t)row * 128 + (col0 - C_VA)) = pack8(v);
    } else if (col0 < C_CKV) {
        *(u32x4*)((bf16_t*)(c.ws + WS_CQ) + (size_t)row * 256 + (col0 - C_CQ)) = pack8(v);
    } else if (col0 < C_U) {
        *(u32x4*)((bf16_t*)(c.ws + WS_CKV) + (size_t)row * 256 + (col0 - C_CKV)) = pack8(v);
    } else if (col0 < C_G) {
        *(u32x4*)((bf16_t*)(c.ws + WS_U) + (size_t)row * 512 + (col0 - C_U)) = pack8(v);
    } else if (col0 < C_KR) {
        unsigned q[8];
#pragma unroll
        for (int i = 0; i < 8; ++i) { const float s = __builtin_amdgcn_rcpf(1.f + __builtin_amdgcn_exp2f(v[i] * (-LOG2E))) * 255.f + 0.5f; q[i] = max((unsigned)s, 1u); }
        u32x2 w; w.x = q[0] | (q[1] << 8) | (q[2] << 16) | (q[3] << 24); w.y = q[4] | (q[5] << 8) | (q[6] << 16) | (q[7] << 24);
        *(u32x2*)(c.dout + DO_G + (size_t)row * 3072 + (col0 - C_G)) = w;
    } else if (col0 < C_END) {
        const int w0 = col0 - C_KR;
        if (xrow) {
#pragma unroll
            for (int i = 0; i < 4; ++i) { const float cx = tb[i >> 1][2 * (i & 1)], sx = tb[i >> 1][2 * (i & 1) + 1]; const float a = v[2 * i], b = v[2 * i + 1]; v[2 * i] = a * cx - b * sx; v[2 * i + 1] = a * sx + b * cx; }
        }
        *(u32x4*)((bf16_t*)(c.dout + DO_KR) + (size_t)row * 32 + w0) = pack8(v);
    }
}
DEV const f32x4* inproj_tab(const Ctx& c, int row, int col0) {
    const int pos = row & (SEQ - 1);
    if (col0 < C_VA) { const int p0 = (col0 & 63) >> 1; const int pp = (p0 < 16) ? (pos >> 6) : (pos & 63); return (const f32x4*)((const float2*)(c.ws + WS_TABA) + pp * 16 + (p0 & 15)); }
    const int p0 = (col0 - C_KR) >> 1; const int pp = (p0 < 8) ? (pos >> 6) : (pos & 63); return (const f32x4*)((const float2*)(c.ws + WS_TABB) + pp * 8 + (p0 & 7));
}
DEV void epi_upq(const Ctx& c, int row, int col0, const float (&vin)[8], float rs) {
    float v[8];
#pragma unroll
    for (int i = 0; i < 8; ++i) v[i] = vin[i] * rs;
    const int w0 = col0 % 96;
    if (w0 >= 64 && row < RX) {
        const int pos = row & (SEQ - 1); const int p0 = (w0 - 64) >> 1; const int pp = (p0 < 8) ? (pos >> 6) : (pos & 63);
        const float2* tab = (const float2*)(c.ws + WS_TABB) + pp * 8 + (p0 & 7);
#pragma unroll
        for (int i = 0; i < 4; ++i) { const float2 cs = tab[i]; const float a = v[2 * i], b = v[2 * i + 1]; v[2 * i] = a * cs.x - b * cs.y; v[2 * i + 1] = a * cs.y + b * cs.x; }
    }
    *(u32x4*)((bf16_t*)(c.ws + WS_QB) + (size_t)row * 768 + col0) = pack8(v);
}
DEV void epi_upkv(const Ctx& c, int row, int col0, const float (&vin)[8], float rs) {
    float v[8];
#pragma unroll
    for (int i = 0; i < 8; ++i) v[i] = vin[i] * rs;
    const int h = col0 >> 7, w0 = col0 & 127;
    if (w0 < 64) *(u32x4*)((bf16_t*)(c.ws + WS_KNB) + (size_t)row * 512 + h * 64 + w0) = pack8(v);
    else *(u32x4*)((bf16_t*)(c.ws + WS_VB) + (size_t)row * 512 + h * 64 + (w0 - 64)) = pack8(v);
}
DEV void load_gates8(const Ctx& c, int row, int col, float (&g)[8]) {
    const u32x2 w = *(const u32x2*)(c.dout + DO_G + (size_t)row * 3072 + col);
    g[0] = (float)(w.x & 255u); g[1] = (float)((w.x >> 8) & 255u); g[2] = (float)((w.x >> 16) & 255u); g[3] = (float)(w.x >> 24);
    g[4] = (float)(w.y & 255u); g[5] = (float)((w.y >> 8) & 255u); g[6] = (float)((w.y >> 16) & 255u); g[7] = (float)(w.y >> 24);
}
namespace pg8 {
#define PG8_LAS __attribute__((address_space(3)))
typedef short bf16x8 __attribute__((ext_vector_type(8)));
constexpr int BM = 256, BK = 64, HALF = 128, HTB = HALF * BK * 2, STAGE_BYTES = 8 * HTB, NXCD = 8, WGM = 8;
DEV int lds_byte(int r, int c) { const int st = (r >> 4) * 2 + (c >> 5), rr = r & 15, cc = c & 31, ob = rr * 64 + cc * 2; return st * 1024 + (ob ^ (((ob >> 9) & 1) << 5)); }
DEV void stage_rc(int b, int& R_, int& C_) { const int st = b / 1024, sb = b % 1024, swz = sb ^ (((sb >> 9) & 1) << 5); R_ = (st >> 1) * 16 + swz / 64; C_ = (st & 1) * 32 + (swz % 64) / 2; }
DEV int perm32(int rho) { const int n = rho >> 4, i = rho & 15; return 8 * (i >> 2) + 4 * n + (i & 3); }

struct Unit { const bf16_t* A; const bf16_t* Bt; int lda; int kstepA; int row0, col0; int aux; int keep; const int* gl; int gn; };

struct TileOrder { int nM, nN, nwg, G, c;
    DEV void init(int nM_, int nN_, int G_, int c_) { nM = nM_; nN = nN_; nwg = nM * nN; G = G_; c = c_; }
    DEV bool get(int i, int& pm, int& pn) const {
        const long L = (long)i * G + c; if (L >= nwg) return false;
        int wgid = (int)L; { const int q = nwg / NXCD, r = nwg % NXCD, xcd = wgid % NXCD, off = wgid / NXCD; wgid = (xcd < r ? xcd * (q + 1) : r * (q + 1) + (xcd - r) * q) + off; }
        const int nig = WGM * nN, gid = wgid / nig, fm = gid * WGM, gsz = (nM - fm) < WGM ? (nM - fm) : WGM;
        pm = fm + ((wgid % nig) % gsz); pn = (wgid % nig) / gsz; return true; } };

template <bool GATHER>
DEV void calc_voA(const Unit& u, unsigned (&vo)[2][2], const int (&Rr)[2], const int (&Cc)[2]) {
#pragma unroll
    for (int h = 0; h < 2; ++h)
#pragma unroll
        for (int i = 0; i < 2; ++i) { const int r = h * HALF + Rr[i]; int srow = r;
            if (GATHER) srow = (r < u.gn) ? (u.gl[r] >> 1) : 0;
            vo[h][i] = (unsigned)(srow * u.lda + Cc[i]) * 2u; }
}

template <class Epi, class Sched, bool GATHER>
DEV void gemm_phase(PG8_LAS unsigned char* lds, const int K, const Sched& S, const Epi& E) {
    const int tid = threadIdx.x, wid = __builtin_amdgcn_readfirstlane(tid >> 6), lane = tid & 63, wr = wid >> 2, wc = wid & 3, fr = lane & 15, fq = lane >> 4;
    const int nt = K / BK;
    int Rr[2], Cc[2]; unsigned voffB[2];
#pragma unroll
    for (int i = 0; i < 2; ++i) { stage_rc(tid * 16 + i * 8192, Rr[i], Cc[i]); const int Rb = (Rr[i] & ~31) + perm32(Rr[i] & 31); voffB[i] = (unsigned)(Rb * K + Cc[i]) * 2u; }
    const size_t kstep = (size_t)(BK * 2);
    const size_t hstepB = (size_t)HALF * K * 2;
    const unsigned ldsw = (unsigned)wid * 1024u;
    const int aoff = lds_byte(wr * 64 + fr, fq * 8), boff = lds_byte(wc * 32 + fr, fq * 8);
#define PG8_SA(b, h) (((b) * 2 + (h)) * HTB)
#define PG8_SB(b, h) ((4 + (b) * 2 + (h)) * HTB)
#define PG8_STAGE(bufoff, gbase, voff) do { _Pragma("unroll") for (int _i = 0; _i < 2; ++_i) \
        __builtin_amdgcn_global_load_lds((const unsigned*)((const char*)(gbase) + (voff)[_i]), (PG8_LAS unsigned*)(lds + (bufoff) + ldsw + _i * 8192), 16, 0, 0); } while (0)
#define PG8_STAGE_A(bufoff, gbase, h, lda_, vo_) do { _Pragma("unroll") for (int _i = 0; _i < 2; ++_i) { \
        const unsigned _o = GATHER ? (vo_)[h][_i] : (unsigned)(((h) * HALF + Rr[_i]) * (lda_) + Cc[_i]) * 2u; \
        __builtin_amdgcn_global_load_lds((const unsigned*)((const char*)(gbase) + _o), (PG8_LAS unsigned*)(lds + (bufoff) + ldsw + _i * 8192), 16, 0, 0); } } while (0)
#define PG8_LDA(dst, b, h) do { _Pragma("unroll") for (int m = 0; m < 4; ++m) _Pragma("unroll") for (int k = 0; k < 2; ++k) dst[m][k] = *(const PG8_LAS bf16x8*)(lds + PG8_SA(b, h) + aoff + m * 2048 + k * 1024); } while (0)
#define PG8_LDB(dst, b, h) do { _Pragma("unroll") for (int n = 0; n < 2; ++n) _Pragma("unroll") for (int k = 0; k < 2; ++k) dst[n][k] = *(const PG8_LAS bf16x8*)(lds + PG8_SB(b, h) + boff + n * 2048 + k * 1024); } while (0)
#define PG8_MMA(ai, bj, At, Bt) do { __builtin_amdgcn_s_setprio(1); _Pragma("unroll") for (int m = 0; m < 4; ++m) _Pragma("unroll") for (int n = 0; n < 2; ++n) _Pragma("unroll") for (int k = 0; k < 2; ++k) \
        acc[ai][bj][m][n] = __builtin_amdgcn_mfma_f32_16x16x32_bf16(Bt[n][k], At[m][k], acc[ai][bj][m][n], 0, 0, 0); __builtin_amdgcn_s_setprio(0); } while (0)
#define PG8_WAIT_V(n) asm volatile("s_waitcnt vmcnt(" #n ")" ::: "memory")
#define PG8_WAIT_L(n) asm volatile("s_waitcnt lgkmcnt(" #n ")" ::: "memory")
#define PG8_BAR __builtin_amdgcn_s_barrier()
#define PG8_SCHED __builtin_amdgcn_sched_barrier(0)
    Unit cur, nxt; int ui = 0;
    if (!S.next(0, cur)) return;
    f32x4 acc[2][2][4][2];
#pragma unroll
    for (int a = 0; a < 2; ++a)
#pragma unroll
        for (int b = 0; b < 2; ++b)
#pragma unroll
            for (int m = 0; m < 4; ++m)
#pragma unroll
                for (int n = 0; n < 2; ++n) acc[a][b][m][n] = (f32x4){0.f, 0.f, 0.f, 0.f};
    bf16x8 At[4][2], B0[2][2], B1[2][2];
    unsigned voA[2][2], nvoA[2][2];
    if (GATHER) calc_voA<GATHER>(cur, voA, Rr, Cc);
    const char* cA = (const char*)cur.A; const char* cB = (const char*)cur.Bt;
    PG8_STAGE(PG8_SB(0, 0), cB, voffB); PG8_STAGE(PG8_SB(0, 1), cB + hstepB, voffB); PG8_STAGE_A(PG8_SA(0, 0), cA, 0, cur.lda, voA); PG8_STAGE_A(PG8_SA(0, 1), cA, 1, cur.lda, voA);
    if (wr == 1) PG8_BAR;
    PG8_WAIT_V(2); PG8_BAR;
    PG8_STAGE(PG8_SB(1, 0), cB + kstep, voffB); PG8_STAGE_A(PG8_SA(1, 0), cA + cur.kstepA, 0, cur.lda, voA); PG8_STAGE(PG8_SB(1, 1), cB + hstepB + kstep, voffB);
    PG8_WAIT_V(6); PG8_BAR;
    for (;;) {
        const bool has_next = S.next(ui + 1, nxt);
        const char* nA = has_next ? (const char*)nxt.A : cA; const char* nB = has_next ? (const char*)nxt.Bt : cB;
        if (GATHER && has_next) calc_voA<GATHER>(nxt, nvoA, Rr, Cc);
        else if (GATHER) {
#pragma unroll
            for (int h = 0; h < 2; ++h)
#pragma unroll
                for (int i = 0; i < 2; ++i) nvoA[h][i] = voA[h][i]; }
#pragma unroll 1
        for (int t = 0; t < nt; t += 2) {
            const bool last = (t == nt - 2);
            const char* a1 = cA + (size_t)(t + 1) * cur.kstepA;
            const char* a2 = last ? nA : cA + (size_t)(t + 2) * cur.kstepA; const char* b2 = last ? nB : cB + (size_t)(t + 2) * kstep;
            const char* a3 = a2 + ((last && has_next) ? nxt.kstepA : cur.kstepA); const char* b3 = b2 + kstep;
            unsigned v2[2][2]; const int lda2 = (last && has_next) ? nxt.lda : cur.lda;
            if (GATHER) {
#pragma unroll
                for (int h = 0; h < 2; ++h)
#pragma unroll
                    for (int i = 0; i < 2; ++i) v2[h][i] = last ? nvoA[h][i] : voA[h][i]; }
            PG8_LDB(B0, 0, 0); PG8_LDB(B1, 0, 1); PG8_SCHED; PG8_LDA(At, 0, 0); PG8_STAGE_A(PG8_SA(1, 1), a1, 1, cur.lda, voA);
            PG8_WAIT_V(8); PG8_WAIT_L(0); PG8_BAR; PG8_MMA(0, 0, At, B0); PG8_MMA(0, 1, At, B1); PG8_BAR; PG8_SCHED;
            PG8_LDA(At, 0, 1); PG8_STAGE(PG8_SB(0, 0), b2, voffB); PG8_STAGE(PG8_SB(0, 1), b2 + hstepB, voffB); PG8_STAGE_A(PG8_SA(0, 0), a2, 0, lda2, v2);
            PG8_WAIT_V(8); PG8_WAIT_L(0); PG8_BAR; PG8_MMA(1, 0, At, B0); PG8_MMA(1, 1, At, B1); PG8_BAR; PG8_SCHED;
            PG8_LDB(B0, 1, 0); PG8_LDB(B1, 1, 1); PG8_SCHED; PG8_LDA(At, 1, 0); PG8_STAGE_A(PG8_SA(0, 1), a2, 1, lda2, v2);
            PG8_WAIT_V(8); PG8_WAIT_L(0); PG8_BAR; PG8_MMA(0, 0, At, B0); PG8_MMA(0, 1, At, B1); PG8_BAR; PG8_SCHED;
            PG8_LDA(At, 1, 1); PG8_STAGE(PG8_SB(1, 0), b3, voffB); PG8_STAGE(PG8_SB(1, 1), b3 + hstepB, voffB); PG8_STAGE_A(PG8_SA(1, 0), a3, 0, lda2, v2);
            PG8_WAIT_V(8); PG8_WAIT_L(0); PG8_BAR; PG8_MMA(1, 0, At, B0); PG8_MMA(1, 1, At, B1); PG8_BAR; PG8_SCHED;
        }
        if (wr == 0) PG8_BAR;
        { int fr_ = fr, fq_ = fq, wr_ = wr, wc_ = wc;
          asm volatile("" : "+v"(fr_), "+v"(fq_)); asm volatile("" : "+s"(wr_), "+s"(wc_));
          E(acc, cur, wr_, wc_, fr_, fq_); }
        if (!has_next) break;
        if (!cur.keep) {
#pragma unroll
            for (int a = 0; a < 2; ++a)
#pragma unroll
                for (int b = 0; b < 2; ++b)
#pragma unroll
                    for (int m = 0; m < 4; ++m)
#pragma unroll
                        for (int n = 0; n < 2; ++n) acc[a][b][m][n] = (f32x4){0.f, 0.f, 0.f, 0.f}; }
        cur = nxt; cA = nA; cB = nB; ++ui;
        if (GATHER) {
#pragma unroll
            for (int h = 0; h < 2; ++h)
#pragma unroll
                for (int i = 0; i < 2; ++i) voA[h][i] = nvoA[h][i]; }
        if (wr == 1) PG8_BAR;
    }
    PG8_WAIT_V(0);
    PG8_BAR;
#undef PG8_SA
#undef PG8_SB
#undef PG8_STAGE
#undef PG8_STAGE_A
#undef PG8_LDA
#undef PG8_LDB
#undef PG8_MMA
#undef PG8_WAIT_V
#undef PG8_WAIT_L
#undef PG8_BAR
#undef PG8_SCHED
}
template <class F> struct Epi8 { F f;
    DEV void operator()(f32x4 (&acc)[2][2][4][2], const Unit& u, int wr, int wc, int fr, int fq) const {
#pragma unroll
        for (int ai = 0; ai < 2; ++ai)
#pragma unroll
            for (int m = 0; m < 4; ++m) { const int row = u.row0 + ai * HALF + wr * 64 + m * 16 + fr;
#pragma unroll
                for (int bj = 0; bj < 2; ++bj) { const int col0 = u.col0 + bj * HALF + wc * 32 + 8 * fq;
                    float v[8]; const f32x4 x0 = acc[ai][bj][m][0], x1 = acc[ai][bj][m][1];
                    v[0] = x0[0]; v[1] = x0[1]; v[2] = x0[2]; v[3] = x0[3]; v[4] = x1[0]; v[5] = x1[1]; v[6] = x1[2]; v[7] = x1[3];
                    f(u, row, col0, v); asm volatile("" ::: "memory"); } } } };
}

DEV void phase_p0(const Ctx& c) {
    const Params& p = *c.p;
    if (blockIdx.x == 0 && c.tid < 64) ((int*)(c.ws + WS_CNT))[c.tid] = 0;
    if (c.gtid < 64 * 16) { const int pos = c.gtid >> 4, i = c.gtid & 15; const float inv = powf(10000.f, -(float)(2 * i) / 32.f); const float ang = (float)pos * inv;
        ((float2*)(c.ws + WS_TABA))[c.gtid] = make_float2(cosf(ang), sinf(ang)); }
    else if (c.gtid < 64 * 16 + 64 * 8) { const int g = c.gtid - 1024; const int pos = g >> 3, i = g & 7; const float inv = powf(10000.f, -(float)(2 * i) / 16.f); const float ang = (float)pos * inv;
        ((float2*)(c.ws + WS_TABB))[g] = make_float2(cosf(ang), sinf(ang)); }
    float* sc = (float*)c.lds;
    float* red = sc + 9 * 1024;
    for (int i = c.tid; i < 9 * 1024; i += 512) { const float v = (i < 8 * 1024) ? p.in[I_C + c.z][i] : p.in[I_CCTX + c.z][i - 8 * 1024]; sc[i] = v * sigmoidf_(v); }
    __syncthreads();
    for (int item = blockIdx.x; item < 192; item += c.G) {
        const int l = item / 96, nb = item % 96, n = nb * 64 + c.lane;
        const float* W = p.in[I_WMOD + c.z] + (size_t)l * 1024 * 6144 + n;
        float acc[9];
#pragma unroll
        for (int j = 0; j < 9; ++j) acc[j] = 0.f;
#pragma unroll 1
        for (int k0 = c.wave * 128; k0 < c.wave * 128 + 128; k0 += 32) { float w[32];
#pragma unroll
            for (int i = 0; i < 32; ++i) w[i] = W[(size_t)(k0 + i) * 6144];
#pragma unroll
            for (int i = 0; i < 32; ++i)
#pragma unroll
                for (int j = 0; j < 9; ++j) acc[j] += sc[j * 1024 + k0 + i] * w[i]; }
#pragma unroll
        for (int j = 0; j < 9; ++j) red[(c.wave * 9 + j) * 64 + c.lane] = acc[j];
        __syncthreads();
        for (int i = c.tid; i < 576; i += 512) { const int j = i >> 6, ln = i & 63; float s = 0.f;
#pragma unroll
            for (int w = 0; w < 8; ++w) s += red[(w * 9 + j) * 64 + ln];
            ((float*)(c.ws + WS_MOD))[(size_t)(l * 9 + j) * 6144 + nb * 64 + ln] = s + p.in[I_BMOD + c.z][l * 6144 + nb * 64 + ln]; }
        __syncthreads();
    }
}

DEV void tr_item(const float* W, int ldn, int K, int k0, int nsrc0, bf16_t* WT, int d0, float* scr, int lane, const float* kscale, bool zero) {
#pragma unroll 8
    for (int i = 0; i < 32; ++i) { const int kk = 2 * i + (lane >> 5); float v = 0.f;
        if (!zero) { v = W[(size_t)(k0 + kk) * ldn + nsrc0 + (lane & 31)]; if (kscale) v *= kscale[k0 + kk]; }
        scr[kk * 33 + (lane & 31)] = v; }
    __builtin_amdgcn_s_waitcnt(0xc07f); __builtin_amdgcn_wave_barrier();
    const int ch = lane & 7;
#pragma unroll
    for (int j = 0; j < 4; ++j) { const int n = (lane >> 3) + 8 * j; const float* s = scr + (8 * ch) * 33 + n;
        u32x4 o; o.x = pk2(s[0], s[33]); o.y = pk2(s[2 * 33], s[3 * 33]); o.z = pk2(s[4 * 33], s[5 * 33]); o.w = pk2(s[6 * 33], s[7 * 33]);
        *(u32x4*)(WT + (size_t)(d0 + n) * K + k0 + 8 * ch) = o; }
    __builtin_amdgcn_s_waitcnt(0xc07f); __builtin_amdgcn_wave_barrier();
}
constexpr int CV_IN = 8 * 20, CV_UQ = 2 * 3, CV_UKV = 2 * 4, CV_BR = 4 * 4, CV_OUT = 8 * 4, CV_GU = NEXP * 8 * 2, CV_DN = NEXP * 2 * 4;
constexpr int CV_NITEMS = CV_IN + CV_UQ + CV_UKV + 2 * CV_BR + CV_OUT + CV_GU + CV_DN, CV_SPLIT = 600;
DEV void tr_wg_item(const Ctx& c, const float* W, int ldn, int K, int k0, int d0, int kind, bf16_t* WT, const float* kscale) {
    float* tile = (float*)c.lds;
    const int r8 = c.tid >> 6, c4 = (c.tid & 63) * 4;
    const int dblk = d0 + (c4 & ~31); int sblk;
    if (kind == 1) sblk = (dblk < C_U) ? dblk : (dblk < C_KR) ? dblk + 32 : (dblk < C_END) ? dblk - C_KR + 1280 : -1;
    else if (kind == 2) { const int pn = dblk >> 8, w = dblk & 255; sblk = (w < 128) ? (128 * pn + w) : (256 + 128 * pn + (w - 128)); }
    else sblk = dblk;
    f32x4 v[16];
#pragma unroll
    for (int it = 0; it < 16; ++it) { const int kk = it * 8 + r8; v[it] = (f32x4){0.f, 0.f, 0.f, 0.f};
        if (sblk >= 0) v[it] = *(const f32x4*)(W + (size_t)(k0 + kk) * ldn + sblk + (c4 & 31)); }
    __syncthreads();
#pragma unroll
    for (int it = 0; it < 16; ++it) { const int kk = it * 8 + r8; f32x4 t = v[it]; if (kscale) t = t * kscale[k0 + kk];
        float* d = tile + kk * 257 + c4; d[0] = t.x; d[1] = t.y; d[2] = t.z; d[3] = t.w; }
    __syncthreads();
#pragma unroll
    for (int j = 0; j < 8; ++j) { const int idx = j * 512 + c.tid, ch = idx & 15, n = idx >> 4; const float* sp = tile + (ch * 8) * 257 + n;
        u32x4 o; o.x = pk2(sp[0], sp[257]); o.y = pk2(sp[2 * 257], sp[3 * 257]); o.z = pk2(sp[4 * 257], sp[5 * 257]); o.w = pk2(sp[6 * 257], sp[7 * 257]);
        *(u32x4*)(WT + (size_t)(d0 + n) * K + k0 + 8 * ch) = o; }
}
DEV void convert_weights(const Ctx& c, int l, int wi, int nw, int part) {
    const Params& p = *c.p; unsigned char* wb = c.ws + (l == 0 ? WS_W : WS_W1); float* wre = (float*)(c.ws + WS_WRE + (size_t)l * 131072);
    const int it_lo = (part == 1) ? CV_SPLIT : 0, it_hi = (part == 0) ? CV_SPLIT : CV_NITEMS;
    const int gtid_ = wi * 512 + c.tid, nt_ = nw * 512;
    for (int it = it_lo + wi; it < it_hi; it += nw) {
        int r = it;
        if (r < CV_IN) { tr_wg_item(c, p.in[I_WIN + c.z] + (size_t)l * 1024 * 4896, 4896, 1024, (r / 20) * 128, (r % 20) * 256, 1, (bf16_t*)(wb + W_IN), nullptr); continue; } r -= CV_IN;
        if (r < CV_UQ) { tr_wg_item(c, p.in[I_WUQ + c.z] + (size_t)l * 256 * 768, 768, 256, (r / 3) * 128, (r % 3) * 256, 0, (bf16_t*)(wb + W_UQ), p.in[I_QNG + c.z] + l * 256); continue; } r -= CV_UQ;
        if (r < CV_UKV) { tr_wg_item(c, p.in[I_WUKV + c.z] + (size_t)l * 256 * 1024, 1024, 256, (r / 4) * 128, (r % 4) * 256, 0, (bf16_t*)(wb + W_UKV), p.in[I_KVNG + c.z] + l * 256); continue; } r -= CV_UKV;
        if (r < CV_BR) { tr_wg_item(c, p.in[I_WBA + c.z] + (size_t)l * 512 * 1024, 1024, 512, (r / 4) * 128, (r % 4) * 256, 0, (bf16_t*)(wb + W_BA), nullptr); continue; } r -= CV_BR;
        if (r < CV_BR) { tr_wg_item(c, p.in[I_WBB + c.z] + (size_t)l * 512 * 1024, 1024, 512, (r / 4) * 128, (r % 4) * 256, 0, (bf16_t*)(wb + W_BB), nullptr); continue; } r -= CV_BR;
        if (r < CV_OUT) { tr_wg_item(c, p.in[I_WOUT + c.z] + (size_t)l * 1024 * 1024, 1024, 1024, (r / 4) * 128, (r % 4) * 256, 0, (bf16_t*)(wb + W_OUT), nullptr); continue; } r -= CV_OUT;
        if (r < CV_GU) { const int e = r / 16, q = r % 16; tr_wg_item(c, p.in[I_WGU + c.z] + ((size_t)l * NEXP + e) * 1024 * 512, 512, 1024, (q / 2) * 128, (q % 2) * 256, 2, (bf16_t*)(wb + W_GU) + (size_t)e * 512 * 1024, nullptr); continue; } r -= CV_GU;
        { const int e = r / 8, q = r % 8; tr_wg_item(c, p.in[I_WDN + c.z] + ((size_t)l * NEXP + e) * 256 * 1024, 1024, 256, (q / 4) * 128, (q % 4) * 256, 0, (bf16_t*)(wb + W_DN) + (size_t)e * 1024 * 256, nullptr); }
    }
    __syncthreads();
    if (part == 1) return;
    for (int i = gtid_; i < 1024 * 32; i += nt_) { const int u8 = i & 7, j16 = (i >> 3) & 15, kq = (i >> 7) & 3, half = (i >> 9) & 1, cc2 = i >> 10;
        wre[i] = p.in[I_WRE + c.z][(size_t)l * 1024 * 32 + (size_t)(32 * cc2 + 8 * kq + u8) * 32 + 16 * half + j16]; }
    const float* wp = p.in[I_WPOOL + c.z] + (size_t)l * 4 * 128 * 128; const float* ps = p.in[I_PSCALE + c.z] + l * 512; const float* wc = p.in[I_WBC + c.z] + (size_t)l * 512 * 1024;
    for (int item = gtid_; item < 64 * 1024; item += nt_) {
        const int kg = item >> 10, n = item & 1023, g = kg >> 4, i0 = (kg & 15) * 8;
        float acc[8];
#pragma unroll
        for (int i = 0; i < 8; ++i) acc[i] = 0.f;
        for (int j = 0; j < 128; ++j) { const float b = ps[128 * g + j] * wc[(size_t)(128 * g + j) * 1024 + n];
#pragma unroll
            for (int i = 0; i < 8; ++i) acc[i] += wp[(size_t)(g * 128 + i0 + i) * 128 + j] * b; }
        *(u32x4*)((bf16_t*)(wb + W_BC) + (size_t)n * 512 + kg * 8) = pack8(acc);
    }
}

struct RowRaw { f32x4 x[4]; u32x2 h[4], y0[4], y1[4]; };
DEV void rows_fetch(const Ctx& c, int l, int r, RowRaw& q) {
    if (l == 0) { const float* src = (r < RX) ? c.p->in[I_X + c.z] + (size_t)r * DM : c.p->in[I_CTX + c.z] + (size_t)(r - RX) * DM;
#pragma unroll
        for (int j = 0; j < 4; ++j) q.x[j] = *(const f32x4*)(src + 4 * c.lane + 256 * j);
    } else { const bf16_t* H = (const bf16_t*)(c.ws + WS_H) + (size_t)r * DM; const bf16_t* Y = (const bf16_t*)(c.ws + WS_YTOK) + (size_t)r * 2048;
#pragma unroll
        for (int j = 0; j < 4; ++j) { const int col = 4 * c.lane + 256 * j; q.h[j] = *(const u32x2*)(H + col); q.y0[j] = *(const u32x2*)(Y + col); q.y1[j] = *(const u32x2*)(Y + 1024 + col); } }
}
struct RowPar { f32x4 gm[4], sh[4], sc[4], g2[4]; int mb; };
DEV void rows_finish(const Ctx& c, int l, bool final_, int r, const RowRaw& q, RowPar& P) {
    const int mb = mod_idx(r);
    if (mb != P.mb) { P.mb = mb;
#pragma unroll
        for (int j = 0; j < 4; ++j) { const int col = 4 * c.lane + 256 * j;
            if (l > 0) P.g2[j] = *(const f32x4*)(modp(c.ws, l - 1, mb, 5) + col);
            if (!final_) { P.sh[j] = *(const f32x4*)(modp(c.ws, l, mb, 0) + col); const f32x4 t = *(const f32x4*)(modp(c.ws, l, mb, 1) + col); P.sc[j] = P.gm[j] * (1.f + t); } } }
    f32x4 v[4];
#pragma unroll
    for (int j = 0; j < 4; ++j) {
        if (l == 0) v[j] = q.x[j];
        else { f32x4 o; const u32x2 hb = q.h[j], y0 = q.y0[j], y1 = q.y1[j]; const f32x4 g = P.g2[j];
            o.x = __uint_as_float(hb.x << 16) + g.x * (__uint_as_float(y0.x << 16) + __uint_as_float(y1.x << 16));
            o.y = __uint_as_float(hb.x & 0xffff0000u) + g.y * (__uint_as_float(y0.x & 0xffff0000u) + __uint_as_float(y1.x & 0xffff0000u));
            o.z = __uint_as_float(hb.y << 16) + g.z * (__uint_as_float(y0.y << 16) + __uint_as_float(y1.y << 16));
            o.w = __uint_as_float(hb.y & 0xffff0000u) + g.w * (__uint_as_float(y0.y & 0xffff0000u) + __uint_as_float(y1.y & 0xffff0000u));
            v[j] = o;
            if (!final_) { u32x2 w; w.x = pk2(o.x, o.y); w.y = pk2(o.z, o.w); *(u32x2*)((bf16_t*)(c.ws + WS_H) + (size_t)r * DM + 4 * c.lane + 256 * j) = w; } } }
    float s = 0.f;
#pragma unroll
    for (int j = 0; j < 4; ++j) s += (v[j].x * v[j].x + v[j].y * v[j].y) + (v[j].z * v[j].z + v[j].w * v[j].w);
    const float rstd = rsqrtf(wave_sum(s) * (1.f / DM) + EPS);
    if (final_) { float* o = (float*)c.dout + (size_t)r * DM;
#pragma unroll
        for (int j = 0; j < 4; ++j) *(f32x4*)(o + 4 * c.lane + 256 * j) = v[j] * rstd * P.gm[j];
    } else { bf16_t* xn = (bf16_t*)(c.ws + WS_XN) + (size_t)r * DM;
#pragma unroll
        for (int j = 0; j < 4; ++j) { const f32x4 t = v[j] * rstd * P.sc[j] + P.sh[j]; u32x2 w; w.x = pk2(t.x, t.y); w.y = pk2(t.z, t.w); *(u32x2*)(xn + 4 * c.lane + 256 * j) = w; } }
}
DEV void phase_rows(const Ctx& c, int l, bool final_) {
    const int nrows = final_ ? RX : R;
    const int r_lo = (int)(((long)c.gw * nrows) / c.NGW), r_hi = (int)(((long)(c.gw + 1) * nrows) / c.NGW);
    RowPar P; P.mb = -1;
    { const float* g = final_ ? c.p->in[I_FING + c.z] : c.p->in[I_GMIX + c.z] + l * DM;
#pragma unroll
      for (int j = 0; j < 4; ++j) P.gm[j] = *(const f32x4*)(g + 4 * c.lane + 256 * j); }
    if (r_lo >= r_hi) return;
    RowRaw A, B;
    rows_fetch(c, l, r_lo, A);
#pragma unroll 1
    for (int r = r_lo; r < r_hi; r += 2) {
        if (r + 1 < r_hi) rows_fetch(c, l, r + 1, B);
        rows_finish(c, l, final_, r, A, P);
        if (r + 1 < r_hi) { if (r + 2 < r_hi) rows_fetch(c, l, r + 2, A); rows_finish(c, l, final_, r + 1, B, P); }
    }
}

template <int RAD> DEV void pool_item(const Ctx& c, int g, int row) {
    const int col = g * 128 + ((int)threadIdx.x & 15) * 8;
    int base, t, L;
    if (row < RX) { base = row & ~(SEQ - 1); t = row & (SEQ - 1); L = SEQ; } else { base = RX + ((row - RX) & ~(LC - 1)); t = (row - RX) & (LC - 1); L = LC; }
    const bf16_t* U = (const bf16_t*)(c.ws + WS_U);
    u32x4 w[2 * RAD + 1];
#pragma unroll
    for (int d = -RAD; d <= RAD; ++d) { int j = t + d; j = j < 0 ? 0 : j; j = j > L - 1 ? L - 1 : j; w[d + RAD] = *(const u32x4*)(U + (size_t)(base + j) * 512 + col); }
    float s[8];
#pragma unroll
    for (int i = 0; i < 8; ++i) s[i] = 0.f;
#pragma unroll
    for (int d = -RAD; d <= RAD; ++d) { const int j = t + d; float tv[8]; unpack8(w[d + RAD], tv); const float ok = (j >= 0 && j < L) ? 1.f : 0.f;
#pragma unroll
        for (int i = 0; i < 8; ++i) s[i] += ok * tv[i]; }
    float me[8]; unpack8(w[RAD], me);
    int lo = t - RAD, hi = t + RAD + 1; if (lo < 0) lo = 0; if (hi > L) hi = L;
    const float invn = 1.f / (float)(hi - lo);
#pragma unroll
    for (int i = 0; i < 8; ++i) s[i] = s[i] * invn - me[i];
    *(u32x4*)((bf16_t*)(c.ws + WS_POOL) + (size_t)row * 512 + col) = pack8(s);
}
DEV void phase_pool(const Ctx& c, int nrows) {
    const int nq = nrows / 4;
    const int tid_ = threadIdx.x, gw_ = (int)blockIdx.x * 8 + (tid_ >> 6);
    for (int it = gw_; it < 4 * nq; it += c.NGW) {
        const int g = it / nq, row = (it - g * nq) * 4 + ((tid_ & 63) >> 4);
        if (g == 0) pool_item<1>(c, 0, row); else if (g == 1) pool_item<2>(c, 1, row); else if (g == 2) pool_item<4>(c, 2, row); else pool_item<8>(c, 3, row);
    }
}

namespace fa {
using bf16x8 = __attribute__((ext_vector_type(8))) short;
using s16x4 = __attribute__((ext_vector_type(4))) short;
using f32x16 = __attribute__((ext_vector_type(16))) float;
#define FA_SBAR() __builtin_amdgcn_sched_barrier(0)
constexpr float THR = 8.f;
DEV int crow(int r, int hi) { return (r & 3) + 8 * (r >> 2) + 4 * hi; }
typedef __bf16 bf16x2_t __attribute__((ext_vector_type(2))); typedef float f32x2_t __attribute__((ext_vector_type(2)));
DEV unsigned cvtpk(float lo, float hi) { const f32x2_t v = {lo, hi}; const bf16x2_t b = __builtin_convertvector(v, bf16x2_t); return __builtin_bit_cast(unsigned, b); }
DEV int v_st(int k, int col) { const int kk = (k & ~0xC) | ((k & 4) << 1) | ((k & 8) >> 1); return ((kk >> 3) * 2 + (col >> 5)) * 512 + ((kk & 7) * 32 + (col & 31)) * 2; }
DEV int v_rd_base(int lane) { return ((lane & 3) << 3) | (((lane >> 2) & 3) << 6) | (((lane >> 4) & 1) << 5) | (((lane >> 5) & 1) << 8); }
constexpr int v_rd_off(int d0, int ks, int half) { return d0 * 512 + ks * 2048 + half * 1024; }
template <int OFF> DEV s16x4 tr_read(int vb) { s16x4 r; asm volatile("ds_read_b64_tr_b16 %0, %1 offset:%2" : "=&v"(r) : "v"(vb), "i"(OFF) : "memory"); return r; }
template <int D0> DEV void pv_one(f32x16& od, int vb, bf16x8 pa0, bf16x8 pa1, bf16x8 pa2, bf16x8 pa3) {
    const s16x4 l0 = tr_read<v_rd_off(D0, 0, 0)>(vb), h0 = tr_read<v_rd_off(D0, 0, 1)>(vb), l1 = tr_read<v_rd_off(D0, 1, 0)>(vb), h1 = tr_read<v_rd_off(D0, 1, 1)>(vb);
    const s16x4 l2 = tr_read<v_rd_off(D0, 2, 0)>(vb), h2 = tr_read<v_rd_off(D0, 2, 1)>(vb), l3 = tr_read<v_rd_off(D0, 3, 0)>(vb), h3 = tr_read<v_rd_off(D0, 3, 1)>(vb);
    asm volatile("s_waitcnt lgkmcnt(0)" ::: "memory"); FA_SBAR();
#define FA_PK(L, H) (bf16x8){L[0], L[1], L[2], L[3], H[0], H[1], H[2], H[3]}
    od = __builtin_amdgcn_mfma_f32_32x32x16_bf16(pa0, FA_PK(l0, h0), od, 0, 0, 0);
    od = __builtin_amdgcn_mfma_f32_32x32x16_bf16(pa1, FA_PK(l1, h1), od, 0, 0, 0);
    od = __builtin_amdgcn_mfma_f32_32x32x16_bf16(pa2, FA_PK(l2, h2), od, 0, 0, 0);
    od = __builtin_amdgcn_mfma_f32_32x32x16_bf16(pa3, FA_PK(l3, h3), od, 0, 0, 0);
#undef FA_PK
}
DEV float max3f(float a, float b, float c) { float r; asm volatile("v_max3_f32 %0, %1, %2, %3" : "=v"(r) : "v"(a), "v"(b), "v"(c)); return r; }
DEV float max2f(float a, float b) { float r; asm volatile("v_max_f32_e32 %0, %1, %2" : "=v"(r) : "v"(a), "v"(b)); return r; }
DEV float halfmax32(const f32x16& p0, const f32x16& p1) {
    float a = __builtin_fmaxf(__builtin_fmaxf(p0[0], p0[1]), p1[0]), b = __builtin_fmaxf(__builtin_fmaxf(p0[2], p0[3]), p1[1]); a = __builtin_fmaxf(__builtin_fmaxf(a, p1[2]), p1[3]);
#pragma unroll
    for (int r = 4; r < 16; r += 4) { a = __builtin_fmaxf(__builtin_fmaxf(a, p0[r]), p0[r + 1]); b = __builtin_fmaxf(__builtin_fmaxf(b, p0[r + 2]), p0[r + 3]);
        a = __builtin_fmaxf(__builtin_fmaxf(a, p1[r]), p1[r + 1]); b = __builtin_fmaxf(__builtin_fmaxf(b, p1[r + 2]), p1[r + 3]); }
    return __builtin_fmaxf(a, b);
}
DEV float mergehalves_max(float m) { auto rr = __builtin_amdgcn_permlane32_swap(__float_as_uint(m), __float_as_uint(m), false, false); return __builtin_fmaxf(__uint_as_float(rr[0]), __uint_as_float(rr[1])); }
template <bool FIRST>
DEV void partialSM(f32x16& p0, f32x16& p1, float& m_reg, f32x16& negm, float& alpha) {
    const float hm = halfmax32(p0, p1);
    alpha = 1.f;
    if (FIRST || __builtin_expect(__any(hm > THR), 0)) {
        const float pm = mergehalves_max(hm);
        const float dl = FIRST ? pm : __builtin_fmaxf(pm, 0.f); m_reg += dl;
#pragma unroll
        for (int r = 0; r < 16; ++r) { p0[r] -= dl; p1[r] -= dl; }
#pragma unroll
        for (int r = 0; r < 16; ++r) negm[r] = -m_reg;
        asm volatile("" : "+v"(negm));
        if (!FIRST) alpha = __builtin_amdgcn_exp2f(-dl);
    }
#pragma unroll
    for (int r = 0; r < 16; ++r) p0[r] = __builtin_amdgcn_exp2f(p0[r]);
}
DEV void finishSM(f32x16& p0, f32x16& p1, float alpha, float& l_reg, bf16x8& pa0, bf16x8& pa1, bf16x8& pa2, bf16x8& pa3) {
#pragma unroll
    for (int r = 0; r < 16; ++r) p1[r] = __builtin_amdgcn_exp2f(p1[r]);
    float ps = p0[0] + p0[1];
#pragma unroll
    for (int r = 2; r < 16; ++r) ps += p0[r];
#pragma unroll
    for (int r = 0; r < 16; ++r) ps += p1[r];
    asm volatile("" : "+v"(ps));
    l_reg = l_reg * alpha + ps;
#define FA_PK4(P, BASE, OUT) do { unsigned a0 = cvtpk(P[BASE + 0], P[BASE + 1]), a1 = cvtpk(P[BASE + 2], P[BASE + 3]); \
    unsigned b0 = cvtpk(P[BASE + 4], P[BASE + 5]), b1 = cvtpk(P[BASE + 6], P[BASE + 7]); \
    u32x4 w = {a0, a1, b0, b1}; OUT = *reinterpret_cast<bf16x8*>(&w); } while (0)
    FA_PK4(p0, 0, pa0); FA_PK4(p0, 8, pa1); FA_PK4(p1, 0, pa2); FA_PK4(p1, 8, pa3);
#undef FA_PK4
}
DEV void glds16(const void* gsrc, unsigned lds_dst) { unsigned keep;
    asm volatile("s_mov_b32 %0, m0\n\ts_mov_b32 m0, %2\n\ts_nop 0\n\tglobal_load_lds_dwordx4 %1, off\n\ts_mov_b32 m0, %0" : "=&s"(keep) : "v"(gsrc), "s"(lds_dst) : "memory"); }
DEV void glds16x3(const void* g0, unsigned d0, const void* g1, unsigned d1, const void* g2, unsigned d2) { unsigned keep;
    asm volatile("s_mov_b32 %0, m0\n\ts_mov_b32 m0, %4\n\ts_nop 0\n\tglobal_load_lds_dwordx4 %1, off\n\ts_mov_b32 m0, %5\n\ts_nop 0\n\tglobal_load_lds_dwordx4 %2, off\n\t"
                 "s_mov_b32 m0, %6\n\ts_nop 0\n\tglobal_load_lds_dwordx4 %3, off\n\ts_mov_b32 m0, %0" : "=&s"(keep) : "v"(g0), "v"(g1), "v"(g2), "s"(d0), "s"(d1), "s"(d2) : "memory"); }
#define FA_WAIT_BAR(N) asm volatile("s_waitcnt vmcnt(" #N ") lgkmcnt(0)\n\ts_barrier" ::: "memory")
constexpr int NSLOT = 4, SHM_V = 8192, SHM_KMAX = 16384, OFF_K = 0, OFF_V = NSLOT * SHM_KMAX, OFF_WS = OFF_V + 8 * SHM_V;
struct Src {
    const bf16_t* Q; int ldq;
    bf16_t* O;
    const bf16_t* K; int ldk;
    const bf16_t* KR;
    const bf16_t* V; int ldv;
    int NT;
    int ctx_row0;
    int x_row0;
    int kloc0;
    int q0;
    float sink_l2;
};
template <int DQ, bool WIN>
DEV void attn_unit(const Src& s, unsigned char* lds) {
    constexpr int ND = DQ / 16, KROWB = (DQ == 96) ? 256 : 128, SHM_K = 64 * KROWB, NKP = (DQ == 96) ? 2 : 1;
    constexpr int NSL = WIN ? 8 : NSLOT;
    int tid_ = threadIdx.x; asm volatile("" : "+v"(tid_));
    const int tid = tid_, wid = __builtin_amdgcn_readfirstlane(tid >> 6), lane = tid & 63, r32 = lane & 31, hi = lane >> 5;
    unsigned char* V_lds = lds + OFF_V; unsigned char* K_lds = lds + OFF_K;
    const unsigned lds0 = (unsigned)(uintptr_t)lds;
    float* wsf = (float*)(lds + OFF_WS) + wid * 64; float* li_l = wsf; float* al_l = wsf + 32;
    float m_reg = 0.f, l_reg = 0.f; f32x16 o[2]; f32x16 negm; bf16x8 qr[ND];
    { float z_; asm volatile("v_mov_b32 %0, 0" : "=v"(z_));
#pragma unroll
      for (int r = 0; r < 16; ++r) { o[0][r] = z_; o[1][r] = z_; negm[r] = z_; } asm volatile("" : "+v"(negm)); }
    int krow_[NKP]; const char* kbase_[NKP]; unsigned kldb_[NKP];
#pragma unroll
    for (int pc = 0; pc < NKP; ++pc) {
        const int pk = NKP * wid + pc, row = (DQ == 96) ? (4 * pk + (lane >> 4)) : (8 * pk + (lane >> 3)), cs = (DQ == 96) ? (lane & 15) : (lane & 7), lc = cs ^ (row & 7);
        krow_[pc] = row;
        if (DQ == 96 && lc >= 8 && lc < 12) { kbase_[pc] = (const char*)s.KR + (lc - 8) * 16; kldb_[pc] = 64u; }
        else { kbase_[pc] = (const char*)s.K + ((lc < 8) ? lc : 0) * 16; kldb_[pc] = (unsigned)s.ldk * 2u; }
    }
    int vkey_; const char* vbase_;
    { const int st = 2 * wid + (lane >> 5), kk = (st >> 1) * 8 + ((lane & 31) >> 2), col = (st & 1) * 32 + (lane & 3) * 8;
        vkey_ = kk; vbase_ = (const char*)s.V + col * 2; }
    const unsigned vldb_ = (unsigned)s.ldv * 2u;
#define FA_KEYROW(t, i) (((t) < 4) ? (s.ctx_row0 + (t) * 64 + (i)) : (s.x_row0 + (WIN ? min(max(s.kloc0 + ((t) - 4) * 64 + (i), 0), SEQ - 1) : (((t) - 4) * 64 + (i)))))
#define FA_DMA(t) do { const int sl_ = (t) & (NSL - 1); \
        _Pragma("unroll") for (int pc = 0; pc < NKP; ++pc) { const unsigned kr_ = (unsigned)FA_KEYROW((t), krow_[pc]); \
            glds16(kbase_[pc] + (size_t)kr_ * kldb_[pc], (unsigned)__builtin_amdgcn_readfirstlane(lds0 + OFF_K + sl_ * SHM_K + (NKP * wid + pc) * 1024)); } \
        { const unsigned vr_ = (unsigned)FA_KEYROW((t), vkey_); glds16(vbase_ + (size_t)vr_ * vldb_, (unsigned)__builtin_amdgcn_readfirstlane(lds0 + OFF_V + sl_ * SHM_V + wid * 1024)); } } while (0)
    const char* pk0_ = nullptr; const char* pk1_ = nullptr; const char* pv_ = nullptr; unsigned kdst0_ = 0, vdst0_ = 0;
    if (!WIN) { pk0_ = kbase_[0] + (size_t)(unsigned)(s.ctx_row0 + 192 + krow_[0]) * kldb_[0]; pk1_ = kbase_[NKP - 1] + (size_t)(unsigned)(s.ctx_row0 + 192 + krow_[NKP - 1]) * kldb_[NKP - 1];
        pv_ = vbase_ + (size_t)(unsigned)(s.ctx_row0 + 192 + vkey_) * vldb_;
        kdst0_ = (unsigned)__builtin_amdgcn_readfirstlane(lds0 + OFF_K + (NKP * wid) * 1024); vdst0_ = (unsigned)__builtin_amdgcn_readfirstlane(lds0 + OFF_V + wid * 1024); }
#define FA_DMAF(t) do { const unsigned kd_ = kdst0_ + (unsigned)((t) & (NSL - 1)) * SHM_K, vd_ = vdst0_ + (unsigned)((t) & (NSL - 1)) * SHM_V; \
        glds16x3(pk0_, kd_, pk1_, kd_ + 1024u, pv_, vd_); \
        pk0_ += (size_t)(64u * kldb_[0]); pk1_ += (size_t)(64u * kldb_[NKP - 1]); pv_ += (size_t)(64u * vldb_); \
        if ((t) == 3) { asm volatile("" ::: "memory");              \
            const long jr_ = (long)s.x_row0 - (long)(s.ctx_row0 + 256); pk0_ += jr_ * (long)kldb_[0]; pk1_ += jr_ * (long)kldb_[NKP - 1]; pv_ += jr_ * (long)vldb_; } } while (0)
#define FA_WAITN(tiles_left) do { if ((tiles_left) >= 2) { if (NKP == 2) FA_WAIT_BAR(6); else FA_WAIT_BAR(4); } else if ((tiles_left) == 1) { if (NKP == 2) FA_WAIT_BAR(3); else FA_WAIT_BAR(2); } else FA_WAIT_BAR(0); } while (0)
#define FA_RESC(a) do { if (__any((a) < 1.f)) { if (hi == 0) al_l[r32] = (a); asm volatile("s_waitcnt lgkmcnt(0)" ::: "memory"); \
        _Pragma("unroll") for (int r = 0; r < 16; ++r) { const float f_ = al_l[crow(r, hi)]; o[0][r] *= f_; o[1][r] *= f_; } } } while (0)
#define FA_KRD(d0_, A_, B_) do { const int cb = (((d0_) & 3) * 16 + hi * 8) * 2;     \
            A_ = *reinterpret_cast<const bf16x8*>(Ks + r32 * KROWB + (cb ^ ((r32 & 7) << 4)) + ((d0_) >> 2) * 128); \
            B_ = *reinterpret_cast<const bf16x8*>(Ks + (32 + r32) * KROWB + (cb ^ ((r32 & 7) << 4)) + ((d0_) >> 2) * 128); } while (0)
#define FA_QKT(p0, p1, t) do { const unsigned char* Ks = K_lds + ((t) & (NSL - 1)) * SHM_K; p0 = negm; p1 = negm; bf16x8 ka_, kb_, kc_, kd_; \
        FA_KRD(0, ka_, kb_); \
        _Pragma("unroll") for (int d0 = 0; d0 < ND; d0 += 2) { \
            FA_KRD(d0 + 1, kc_, kd_); asm volatile("" ::: "memory"); \
            p0 = __builtin_amdgcn_mfma_f32_32x32x16_bf16(ka_, qr[d0], p0, 0, 0, 0); \
            p1 = __builtin_amdgcn_mfma_f32_32x32x16_bf16(kb_, qr[d0], p1, 0, 0, 0); \
            if (d0 + 2 < ND) { FA_KRD(d0 + 2, ka_, kb_); asm volatile("" ::: "memory"); } \
            p0 = __builtin_amdgcn_mfma_f32_32x32x16_bf16(kc_, qr[d0 + 1], p0, 0, 0, 0); \
            p1 = __builtin_amdgcn_mfma_f32_32x32x16_bf16(kd_, qr[d0 + 1], p1, 0, 0, 0); } \
        if (WIN) { const int kb = s.kloc0 + ((t) - 4) * 64, dk_ = kb - (s.q0 + wid * 32);     \
            if ((t) >= 4 && !(dk_ >= -97 && dk_ <= 65 && kb >= 0 && kb + 63 < SEQ)) { const int qp = s.q0 + wid * 32 + r32; \
            const int lo_ = max(qp - 128, 0), hi_ = min(qp + 128, SEQ - 1); const unsigned span_ = (unsigned)(hi_ - lo_); const int kbl_ = kb + 4 * hi - lo_;     \
            _Pragma("unroll") for (int r = 0; r < 16; ++r) { const int c_ = (r & 3) + 8 * (r >> 2); \
                if ((unsigned)(kbl_ + c_) > span_) p0[r] = -INFINITY; \
                if ((unsigned)(kbl_ + c_ + 32) > span_) p1[r] = -INFINITY; } } } } while (0)
#define FA_PV(t) do { const int vb_ = (int)(uintptr_t)V_lds + ((t) & (NSL - 1)) * SHM_V + v_rd_base(lane); pv_one<0>(o[0], vb_, pa0, pa1, pa2, pa3); pv_one<1>(o[1], vb_, pa0, pa1, pa2, pa3); } while (0)
#define FA_VU(u, Y0, Y1) do { if ((u) < 8) { Y1[2 * ((u) & 7)] = __builtin_amdgcn_exp2f(Y1[2 * ((u) & 7)]); Y1[2 * ((u) & 7) + 1] = __builtin_amdgcn_exp2f(Y1[2 * ((u) & 7) + 1]); \
            if ((u) == 0) ps_ = Y0[0] + Y0[1]; else { ps_ += Y0[2 * ((u) & 7)]; ps_ += Y0[2 * ((u) & 7) + 1]; } wq_[((u) >> 2) & 3][(u) & 3] = cvtpk(Y0[2 * ((u) & 7)], Y0[2 * ((u) & 7) + 1]); } \
        else { ps_ += Y1[2 * ((u) & 7)]; ps_ += Y1[2 * ((u) & 7) + 1]; wq_[((u) >> 2) & 3][(u) & 3] = cvtpk(Y1[2 * ((u) & 7)], Y1[2 * ((u) & 7) + 1]); } } while (0)
#define FA_GAP(g, Y0, Y1) do { if (ND == 6) { if ((g) < 8) FA_VU((g), Y0, Y1); else { FA_VU(2 * (g) - 8, Y0, Y1); FA_VU(2 * (g) - 7, Y0, Y1); } } \
        else { FA_VU((g), Y0, Y1); FA_VU(8 + (g), Y0, Y1); } asm volatile("" : "+v"(ps_)); FA_SBAR(); } while (0)
#define FA_SEG1(X0, X1, Y0, Y1, alY, t, DOD) do { const unsigned char* Ks = K_lds + ((t) & (NSL - 1)) * SHM_K; bf16x8 ka_, kb_, kc_, kd_; float ps_ = 0.f; u32x4 wq_[4]; \
        FA_KRD(0, ka_, kb_); FA_KRD(1, kc_, kd_); FA_SBAR(); \
        if (WIN) { if ((DOD) && (t) + 2 < NT) FA_DMA((t) + 2); } else if (DOD) FA_DMAF((t) + 2); \
        FA_RESC(alY); FA_SBAR(); \
          \
        _Pragma("unroll") for (int d0 = 0; d0 < ND; d0 += 2) { \
            if (d0 == 0) { X1 = __builtin_amdgcn_mfma_f32_32x32x16_bf16(kb_, qr[0], negm, 0, 0, 0); FA_GAP(0, Y0, Y1); X0 = __builtin_amdgcn_mfma_f32_32x32x16_bf16(ka_, qr[0], negm, 0, 0, 0); FA_GAP(1, Y0, Y1); } \
            else { X1 = __builtin_amdgcn_mfma_f32_32x32x16_bf16(kb_, qr[d0], X1, 0, 0, 0); FA_GAP(2 * d0, Y0, Y1); X0 = __builtin_amdgcn_mfma_f32_32x32x16_bf16(ka_, qr[d0], X0, 0, 0, 0); FA_GAP(2 * d0 + 1, Y0, Y1); } \
            if (d0 + 2 < ND) { FA_KRD(d0 + 2, ka_, kb_); } \
            X1 = __builtin_amdgcn_mfma_f32_32x32x16_bf16(kd_, qr[d0 + 1], X1, 0, 0, 0); FA_GAP(2 * d0 + 2, Y0, Y1); X0 = __builtin_amdgcn_mfma_f32_32x32x16_bf16(kc_, qr[d0 + 1], X0, 0, 0, 0); FA_GAP(2 * d0 + 3, Y0, Y1); \
            if (d0 + 3 < ND) { FA_KRD(d0 + 3, kc_, kd_); } } \
        l_reg = l_reg * (alY) + ps_; \
        pa0 = *reinterpret_cast<bf16x8*>(&wq_[0]); pa1 = *reinterpret_cast<bf16x8*>(&wq_[1]); pa2 = *reinterpret_cast<bf16x8*>(&wq_[2]); pa3 = *reinterpret_cast<bf16x8*>(&wq_[3]); \
        if (WIN) { const int kb = s.kloc0 + ((t) - 4) * 64, dk_ = kb - (s.q0 + wid * 32); \
            if ((t) >= 4 && !(dk_ >= -97 && dk_ <= 65 && kb >= 0 && kb + 63 < SEQ)) { const int qp = s.q0 + wid * 32 + r32; \
            const int lo_ = max(qp - 128, 0), hi_ = min(qp + 128, SEQ - 1); const unsigned span_ = (unsigned)(hi_ - lo_); const int kbl_ = kb + 4 * hi - lo_; \
            _Pragma("unroll") for (int r = 0; r < 16; ++r) { const int c_ = (r & 3) + 8 * (r >> 2); \
                if ((unsigned)(kbl_ + c_) > span_) X0[r] = -INFINITY; \
                if ((unsigned)(kbl_ + c_ + 32) > span_) X1[r] = -INFINITY; } } } } while (0)
#define FA_PKV(L, H) (bf16x8){L[0], L[1], L[2], L[3], H[0], H[1], H[2], H[3]}
#define FA_EXP4(X, b) do { X[(b)] = __builtin_amdgcn_exp2f(X[(b)]); X[(b) + 1] = __builtin_amdgcn_exp2f(X[(b) + 1]); X[(b) + 2] = __builtin_amdgcn_exp2f(X[(b) + 2]); X[(b) + 3] = __builtin_amdgcn_exp2f(X[(b) + 3]); } while (0)
#define FA_SEG2(X0, X1, alX, tp) do { const int vb_ = (int)(uintptr_t)V_lds + ((tp) & (NSL - 1)) * SHM_V + v_rd_base(lane); \
        const s16x4 l0 = tr_read<v_rd_off(0, 0, 0)>(vb_), h0 = tr_read<v_rd_off(0, 0, 1)>(vb_), l1 = tr_read<v_rd_off(0, 1, 0)>(vb_), h1 = tr_read<v_rd_off(0, 1, 1)>(vb_); \
        const s16x4 l2 = tr_read<v_rd_off(0, 2, 0)>(vb_), h2 = tr_read<v_rd_off(0, 2, 1)>(vb_), l3 = tr_read<v_rd_off(0, 3, 0)>(vb_), h3 = tr_read<v_rd_off(0, 3, 1)>(vb_); \
          \
          \
        float a_ = max3f(X1[0], X1[1], X1[2]), c_ = max3f(X1[7], X1[8], X1[9]), b_, d_; a_ = max3f(a_, X1[3], X1[4]); c_ = max3f(c_, X1[10], X1[11]); \
        asm volatile("s_waitcnt lgkmcnt(0)" ::: "memory"); FA_SBAR(); \
        o[0] = __builtin_amdgcn_mfma_f32_32x32x16_bf16(pa0, FA_PKV(l0, h0), o[0], 0, 0, 0); \
        const s16x4 m0_ = tr_read<v_rd_off(1, 0, 0)>(vb_), n0_ = tr_read<v_rd_off(1, 0, 1)>(vb_); a_ = max3f(a_, X1[5], X1[6]); c_ = max3f(c_, X1[12], X1[13]); b_ = max3f(X0[0], X0[1], X0[2]); FA_SBAR(); \
        o[0] = __builtin_amdgcn_mfma_f32_32x32x16_bf16(pa1, FA_PKV(l1, h1), o[0], 0, 0, 0); \
        const s16x4 m1_ = tr_read<v_rd_off(1, 1, 0)>(vb_), n1_ = tr_read<v_rd_off(1, 1, 1)>(vb_); d_ = max3f(X0[7], X0[8], X0[9]); b_ = max3f(b_, X0[3], X0[4]); d_ = max3f(d_, X0[10], X0[11]); FA_SBAR(); \
        o[0] = __builtin_amdgcn_mfma_f32_32x32x16_bf16(pa2, FA_PKV(l2, h2), o[0], 0, 0, 0); \
        const s16x4 m2_ = tr_read<v_rd_off(1, 2, 0)>(vb_), n2_ = tr_read<v_rd_off(1, 2, 1)>(vb_); b_ = max3f(b_, X0[5], X0[6]); d_ = max3f(d_, X0[12], X0[13]); a_ = max3f(a_, c_, X1[14]); FA_SBAR(); \
        o[0] = __builtin_amdgcn_mfma_f32_32x32x16_bf16(pa3, FA_PKV(l3, h3), o[0], 0, 0, 0); \
        const s16x4 m3_ = tr_read<v_rd_off(1, 3, 0)>(vb_), n3_ = tr_read<v_rd_off(1, 3, 1)>(vb_); b_ = max3f(b_, d_, X0[14]); a_ = max3f(a_, X1[15], X0[15]); const float hm_ = max2f(a_, b_); FA_SBAR(); \
        alX = 1.f; \
        if (__builtin_expect(__any(hm_ > THR), 0)) { const float pm_ = mergehalves_max(hm_); const float dl_ = __builtin_fmaxf(pm_, 0.f); m_reg += dl_; \
            _Pragma("unroll") for (int r = 0; r < 16; ++r) { X0[r] -= dl_; X1[r] -= dl_; } \
            _Pragma("unroll") for (int r = 0; r < 16; ++r) negm[r] = -m_reg; \
            asm volatile("" : "+v"(negm)); alX = __builtin_amdgcn_exp2f(-dl_); } \
        asm volatile("s_waitcnt lgkmcnt(0)" ::: "memory"); FA_SBAR(); \
        o[1] = __builtin_amdgcn_mfma_f32_32x32x16_bf16(pa0, FA_PKV(m0_, n0_), o[1], 0, 0, 0); FA_EXP4(X0, 0); asm volatile("" : "+v"(X0)); FA_SBAR(); \
        o[1] = __builtin_amdgcn_mfma_f32_32x32x16_bf16(pa1, FA_PKV(m1_, n1_), o[1], 0, 0, 0); FA_EXP4(X0, 4); asm volatile("" : "+v"(X0)); FA_SBAR(); \
        o[1] = __builtin_amdgcn_mfma_f32_32x32x16_bf16(pa2, FA_PKV(m2_, n2_), o[1], 0, 0, 0); FA_EXP4(X0, 8); asm volatile("" : "+v"(X0)); FA_SBAR(); \
        o[1] = __builtin_amdgcn_mfma_f32_32x32x16_bf16(pa3, FA_PKV(m3_, n3_), o[1], 0, 0, 0); FA_EXP4(X0, 12); asm volatile("" : "+v"(X0)); FA_SBAR(); } while (0)
    const int NT = s.NT;
    FA_DMA(0); FA_DMA(1); FA_DMA(2);
    const bf16_t* Qw = s.Q + (size_t)(wid * 32 + r32) * s.ldq + hi * 8;
#pragma unroll
    for (int d0 = 0; d0 < ND; ++d0) qr[d0] = *reinterpret_cast<const bf16x8*>(Qw + d0 * 16);
    f32x16 pA0, pA1, pB0, pB1; float alA, alB; bf16x8 pa0, pa1, pa2, pa3;
    FA_WAITN(2);
    FA_QKT(pA0, pA1, 0); partialSM<true>(pA0, pA1, m_reg, negm, alA);
    FA_WAITN(1);
    if (!WIN) {
    for (int j = 1; j + 1 < NT; j += 2) {
        FA_SEG1(pB0, pB1, pA0, pA1, alA, j, 1);
        FA_SEG2(pB0, pB1, alB, j - 1);
        FA_WAITN(1);
        FA_SEG1(pA0, pA1, pB0, pB1, alB, j + 1, 1);
        FA_SEG2(pA0, pA1, alA, j);
        FA_WAITN(1);
    }
    FA_SEG1(pB0, pB1, pA0, pA1, alA, NT - 1, 0);
    FA_SEG2(pB0, pB1, alB, NT - 2);
    FA_RESC(alB);
    finishSM(pB0, pB1, alB, l_reg, pa0, pa1, pa2, pa3);
    FA_PV(NT - 1);
    } else if (NT == 12) {
    const int lo_w = wid >> 1;
    FA_DMA(3); FA_DMA(4); FA_DMA(5); FA_DMA(6);
    FA_SEG1(pB0, pB1, pA0, pA1, alA, 1, 0); FA_PV(0); partialSM<false>(pB0, pB1, m_reg, negm, alB);
    FA_WAIT_BAR(8); FA_DMA(7); FA_DMA(8);
    FA_SEG1(pA0, pA1, pB0, pB1, alB, 2, 0); FA_PV(1); partialSM<false>(pA0, pA1, m_reg, negm, alA);
    FA_WAIT_BAR(10); FA_DMA(9);
    FA_SEG1(pB0, pB1, pA0, pA1, alA, 3, 0); FA_PV(2); partialSM<false>(pB0, pB1, m_reg, negm, alB);
    FA_WAIT_BAR(4); FA_DMA(10);
    FA_SEG1(pA0, pA1, pB0, pB1, alB, 4 + lo_w, 0); FA_PV(3); partialSM<false>(pA0, pA1, m_reg, negm, alA);
    FA_WAIT_BAR(4); FA_DMA(11);
    FA_SEG1(pB0, pB1, pA0, pA1, alA, 5 + lo_w, 0); FA_PV(4 + lo_w); partialSM<false>(pB0, pB1, m_reg, negm, alB);
    FA_WAIT_BAR(0);
    FA_SEG1(pA0, pA1, pB0, pB1, alB, 6 + lo_w, 0); FA_PV(5 + lo_w); partialSM<false>(pA0, pA1, m_reg, negm, alA);
    FA_SEG1(pB0, pB1, pA0, pA1, alA, 7 + lo_w, 0); FA_PV(6 + lo_w); partialSM<false>(pB0, pB1, m_reg, negm, alB);
    FA_SEG1(pA0, pA1, pB0, pB1, alB, 8 + lo_w, 0); FA_PV(7 + lo_w); partialSM<false>(pA0, pA1, m_reg, negm, alA);
    FA_RESC(alA);
    finishSM(pA0, pA1, alA, l_reg, pa0, pa1, pa2, pa3);
    FA_PV(8 + lo_w);
    } else { const int NT = 4;
    FA_SEG1(pB0, pB1, pA0, pA1, alA, 1, 1); FA_PV(0); partialSM<false>(pB0, pB1, m_reg, negm, alB);
    FA_WAITN(1);
    FA_SEG1(pA0, pA1, pB0, pB1, alB, 2, 1); FA_PV(1); partialSM<false>(pA0, pA1, m_reg, negm, alA);
    FA_WAITN(0);
    FA_SEG1(pB0, pB1, pA0, pA1, alA, 3, 1); FA_PV(2); partialSM<false>(pB0, pB1, m_reg, negm, alB);
    FA_RESC(alB);
    finishSM(pB0, pB1, alB, l_reg, pa0, pa1, pa2, pa3);
    FA_PV(3);
    }
    { auto rr = __builtin_amdgcn_permlane32_swap(__float_as_uint(l_reg), __float_as_uint(l_reg), false, false); l_reg = __uint_as_float(rr[0]) + __uint_as_float(rr[1]); }
    if (WIN) l_reg += __builtin_amdgcn_exp2f(s.sink_l2 - m_reg);
    int hi_e = hi, r32_e = r32; asm volatile("" : "+v"(hi_e), "+v"(r32_e));
    if (hi_e == 0) li_l[r32_e] = l_reg; asm volatile("s_waitcnt lgkmcnt(0)" ::: "memory");
    bf16_t* Ow = s.O + (size_t)(wid * 32) * s.ldq;
#pragma unroll
    for (int r = 0; r < 16; ++r) { const int orow = crow(r, hi_e); const float rl = __builtin_amdgcn_rcpf(li_l[orow]);
#pragma unroll
        for (int d0 = 0; d0 < 2; ++d0) Ow[(size_t)orow * s.ldq + d0 * 32 + r32_e] = (bf16_t)f2bf(o[d0][r] * rl); }
    FA_WAIT_BAR(0);
#undef FA_KEYROW
#undef FA_DMA
#undef FA_DMAF
#undef FA_WAITN
#undef FA_RESC
#undef FA_QKT
#undef FA_KRD
#undef FA_PV
#undef FA_VU
#undef FA_GAP
#undef FA_SEG1
#undef FA_SEG2
#undef FA_PKV
#undef FA_EXP4
}
}
DEV void phase_attn_fast(const Ctx& c, int l) {
    const bool last = (l == DEPTH - 1);
    const int nx = NB * 8 * 16, nc = last ? 0 : NB * 8;
    const int vcu = (c.G % 8 == 0) ? (int)(blockIdx.x % 8) * (c.G / 8) + (int)(blockIdx.x / 8) : (int)blockIdx.x;
    for (int it = vcu; it < nx + nc; it += c.G) {
        int r = it; const bool ctxq = r >= nx; if (ctxq) r -= nx;
        int b, h, qb;
        if (!ctxq) { qb = r & 15; h = (r >> 4) & 7; b = r >> 7; } else { qb = 0; h = r & 7; b = r >> 3; }
        const int qrow0 = ctxq ? (RX + b * LC) : (b * SEQ + qb * 256);
        fa::Src s; s.ctx_row0 = RX + b * LC; s.x_row0 = b * SEQ; s.q0 = qb * 256;
        s.Q = (const bf16_t*)(c.ws + WS_QB) + (size_t)qrow0 * 768 + h * 96; s.ldq = 768; s.O = (bf16_t*)(c.ws + WS_QB) + (size_t)qrow0 * 768 + h * 96;
        s.K = (const bf16_t*)(c.ws + WS_KNB) + h * 64; s.ldk = 512; s.KR = (const bf16_t*)(c.dout + DO_KR); s.V = (const bf16_t*)(c.ws + WS_VB) + h * 64; s.ldv = 512;
        s.NT = ctxq ? 4 : 68; s.kloc0 = 0; s.sink_l2 = 0.f;
        fa::attn_unit<96, false>(s, c.lds);
    }
    asm volatile("" ::: "memory");
    for (int it = (vcu + c.G - nc) % c.G; it < nx + nc; it += c.G) {
        int r = it; bool ctxq = r >= nx; if (ctxq) r = (r - nx + nc / 2) % (nc > 0 ? nc : 1);
        int b, h, qb;
        if (!ctxq) { qb = r & 15; h = (r >> 4) & 7; b = r >> 7; } else { qb = 0; h = r & 7; b = r >> 3; }
        const int qrow0 = ctxq ? (RX + b * LC) : (b * SEQ + qb * 256);
        fa::Src s; s.ctx_row0 = RX + b * LC; s.x_row0 = b * SEQ; s.q0 = qb * 256;
        const int kvh = h >> 2;
        s.Q = (const bf16_t*)(c.ws + WS_QA) + (size_t)qrow0 * 512 + h * 64; s.ldq = 512; s.O = (bf16_t*)(c.ws + WS_QA) + (size_t)qrow0 * 512 + h * 64;
        s.K = (const bf16_t*)(c.dout + DO_KA) + kvh * 64; s.ldk = 128; s.KR = nullptr; s.V = (const bf16_t*)(c.dout + DO_VA) + kvh * 64; s.ldv = 128;
        s.NT = ctxq ? 4 : 12; s.kloc0 = qb * 256 - 128; s.sink_l2 = c.p->in[I_SINK + c.z][l * 8 + h] * LOG2E;
        fa::attn_unit<64, true>(s, c.lds);
    }
    phase_pool(c, last ? RX : R);
}

typedef float f32x16 __attribute__((ext_vector_type(16)));
DEV void phase_router(const Ctx& c, int l) {
    const Params& p = *c.p; const int nrows = (l == DEPTH - 1) ? RX : R, ntask = nrows / 16;
    int* cnt = (int*)(c.ws + WS_CNT) + l * 32; int* list = (int*)(c.ws + WS_LIST); float* gate = (float*)(c.ws + WS_GATE);
    float* wrg_l = (float*)c.lds; float* gs_l = (float*)(c.lds + 16384) + c.wave * 2048; float* sh_l = gs_l + 1024; float* sc_l = (float*)(c.lds + 16384 + 65536) + c.wave * (16 * 33);
    for (int i = c.tid; i < 1024; i += 512) *(f32x4*)(wrg_l + 4 * i) = *(const f32x4*)(p.in[I_WRG + c.z] + (size_t)l * 4096 + 4 * i);
    __syncthreads();
    const int i_ = c.lane & 15, kq = c.lane >> 4;
    int* sel_l = (int*)(c.lds + 16384 + 65536 + 8 * 16 * 33 * 4); int* lrk_l = sel_l + 256; int* base_l = lrk_l + 256;
    const bool split = (nrows == R) && (c.G == 256);
    const int nt_full = split ? RX / 16 : ntask;
    float* glp_l = (float*)(c.lds + 16384 + 65536 + 8 * 16 * 33 * 4 + 2560);
    bool coop_done = false;
    for (int t = c.gw; ; t += c.NGW) {
        bool coop = false;
        if (t >= nt_full) { if (!split || coop_done) break; coop = true; coop_done = true; }
        int e1 = 0, e2 = 0; float g1v = 0.f, g2v = 0.f;
        const int row0 = coop ? (RX + 8 * (int)blockIdx.x) : t * 16, mb = mod_idx(row0), row = coop ? (row0 + (i_ & 7)) : (row0 + i_);
        const int it_lo = coop ? 2 * c.wave : 0, it_hi = coop ? 2 * c.wave + 2 : 16;
        { const float* g = p.in[I_GFFN + c.z] + l * DM; const float* sh = modp(c.ws, l, mb, 3); const float* scl = modp(c.ws, l, mb, 4);
#pragma unroll
            for (int j = 0; j < 4; ++j) { const int col = 4 * c.lane + 256 * j; const f32x4 gg = *(const f32x4*)(g + col), s1 = *(const f32x4*)(sh + col), s2 = *(const f32x4*)(scl + col);
                f32x4 a; a.x = gg.x * (1.f + s2.x); a.y = gg.y * (1.f + s2.y); a.z = gg.z * (1.f + s2.z); a.w = gg.w * (1.f + s2.w);
                *(f32x4*)(gs_l + col) = a; *(f32x4*)(sh_l + col) = s1; } }
        float rstd;
        { const float* sq = (const float*)(c.dout + DO_SSQH) + (size_t)row * 16; const f32x4 a = *(const f32x4*)sq, b = *(const f32x4*)(sq + 4), d = *(const f32x4*)(sq + 8), e = *(const f32x4*)(sq + 12);
            const float s = (((a.x + a.y) + (a.z + a.w)) + ((b.x + b.y) + (b.z + b.w))) + (((d.x + d.y) + (d.z + d.w)) + ((e.x + e.y) + (e.z + e.w)));
            rstd = rsqrtf(s * (1.f / DM) + EPS); }
        const bf16_t* hrow = (const bf16_t*)(c.ws + WS_H) + (size_t)row * DM + 8 * kq;
        bf16_t* fxrow = (bf16_t*)(c.ws + WS_FX) + (size_t)row * DM + 8 * kq;
        const float* Bp = (const float*)(c.ws + c.wre) + c.lane * 8;
        f32x4 acc0 = {0.f, 0.f, 0.f, 0.f}, acc1 = {0.f, 0.f, 0.f, 0.f}; float gl0 = 0.f, gl1 = 0.f, gl2 = 0.f, gl3 = 0.f;
        u32x4 hc[2], hn[2], hm[2]; f32x4 bc[2][4], bn[2][4];
        { const int n1 = (it_lo + 1 < it_hi ? it_lo + 1 : it_hi - 1) * 2;
#pragma unroll
        for (int q = 0; q < 2; ++q) { hc[q] = *(const u32x4*)(hrow + 32 * (it_lo * 2 + q)); hn[q] = *(const u32x4*)(hrow + 32 * (n1 + q));
#pragma unroll
            for (int v = 0; v < 4; ++v) bc[q][v] = *(const f32x4*)(Bp + (it_lo * 2 + q) * 1024 + (v >> 1) * 512 + (v & 1) * 4); } }
#pragma unroll 1
        for (int it = it_lo; it < it_hi; ++it) {
            const int nb = (it + 1 < it_hi ? it + 1 : it_hi - 1) * 2, nb2 = (it + 2 < it_hi ? it + 2 : it_hi - 1) * 2;
#pragma unroll
            for (int q = 0; q < 2; ++q) {
#pragma unroll
                for (int v = 0; v < 4; ++v) bn[q][v] = *(const f32x4*)(Bp + (nb + q) * 1024 + (v >> 1) * 512 + (v & 1) * 4); }
            asm volatile("" ::: "memory");
#pragma unroll
            for (int q = 0; q < 2; ++q) hm[q] = *(const u32x4*)(hrow + 32 * (nb2 + q));
#pragma unroll
            for (int q = 0; q < 2; ++q) { const int cc2 = it * 2 + q;
                float h8[8]; unpack8(hc[q], h8);
                const f32x4 ga = *(const f32x4*)(gs_l + 32 * cc2 + 8 * kq), gb = *(const f32x4*)(gs_l + 32 * cc2 + 8 * kq + 4), sa = *(const f32x4*)(sh_l + 32 * cc2 + 8 * kq), sb = *(const f32x4*)(sh_l + 32 * cc2 + 8 * kq + 4);
                float fx[8];
#pragma unroll
                for (int u = 0; u < 4; ++u) { fx[u] = h8[u] * rstd * ga[u] + sa[u]; fx[4 + u] = h8[4 + u] * rstd * gb[u] + sb[u]; }
                u32x4 w; w.x = pk2(fx[0], fx[1]); w.y = pk2(fx[2], fx[3]); w.z = pk2(fx[4], fx[5]); w.w = pk2(fx[6], fx[7]); *(u32x4*)(fxrow + 32 * cc2) = w;
#pragma unroll
                for (int u = 0; u < 8; ++u) { acc0 = __builtin_amdgcn_mfma_f32_16x16x4f32(fx[u], bc[q][u >> 2][u & 3], acc0, 0, 0, 0); acc1 = __builtin_amdgcn_mfma_f32_16x16x4f32(fx[u], bc[q][2 + (u >> 2)][u & 3], acc1, 0, 0, 0); }
#pragma unroll
                for (int u = 0; u < 8; ++u) { const f32x4 wg = *(const f32x4*)(wrg_l + (32 * cc2 + 8 * kq + u) * 4); gl0 += fx[u] * wg.x; gl1 += fx[u] * wg.y; gl2 += fx[u] * wg.z; gl3 += fx[u] * wg.w; } }
#pragma unroll
            for (int q = 0; q < 2; ++q) { hc[q] = hn[q]; hn[q] = hm[q];
#pragma unroll
                for (int v = 0; v < 4; ++v) bc[q][v] = bn[q][v]; }
        }
        gl0 += __shfl_xor(gl0, 16); gl1 += __shfl_xor(gl1, 16); gl2 += __shfl_xor(gl2, 16); gl3 += __shfl_xor(gl3, 16);
        gl0 += __shfl_xor(gl0, 32); gl1 += __shfl_xor(gl1, 32); gl2 += __shfl_xor(gl2, 32); gl3 += __shfl_xor(gl3, 32);
        { const float be0 = coop ? 0.f : p.in[I_BRE + c.z][l * 32 + i_], be1 = coop ? 0.f : p.in[I_BRE + c.z][l * 32 + 16 + i_];
#pragma unroll
            for (int r = 0; r < 4; ++r) { sc_l[(4 * kq + r) * 33 + i_] = acc0[r] + be0; sc_l[(4 * kq + r) * 33 + 16 + i_] = acc1[r] + be1; } }
        if (coop) {
            if (kq == 0) { float* gp_ = glp_l + (c.wave * 16 + i_) * 4; gp_[0] = gl0; gp_[1] = gl1; gp_[2] = gl2; gp_[3] = gl3; }
            if (c.tid < 256) sel_l[c.tid] = -1;
            __syncthreads();
            if (c.wave == 0) {
                const float* sc0 = (const float*)(c.lds + 16384 + 65536);
                float a0[4], a1[4];
#pragma unroll
                for (int r = 0; r < 4; ++r) { float x0 = p.in[I_BRE + c.z][l * 32 + i_], x1 = p.in[I_BRE + c.z][l * 32 + 16 + i_];
#pragma unroll
                    for (int w = 0; w < 8; ++w) { x0 += sc0[w * (16 * 33) + (4 * kq + r) * 33 + i_]; x1 += sc0[w * (16 * 33) + (4 * kq + r) * 33 + 16 + i_]; }
                    a0[r] = x0; a1[r] = x1; }
                float t0 = 0.f, t1 = 0.f, t2 = 0.f, t3 = 0.f;
#pragma unroll
                for (int w = 0; w < 8; ++w) { const float* gp_ = glp_l + (w * 16 + i_) * 4; t0 += gp_[0]; t1 += gp_[1]; t2 += gp_[2]; t3 += gp_[3]; }
                gl0 = t0; gl1 = t1; gl2 = t2; gl3 = t3;
                __builtin_amdgcn_s_waitcnt(0xc07f); __builtin_amdgcn_wave_barrier();
#pragma unroll
                for (int r = 0; r < 4; ++r) { sc_l[(4 * kq + r) * 33 + i_] = a0[r]; sc_l[(4 * kq + r) * 33 + 16 + i_] = a1[r]; }
            }
        }
        __builtin_amdgcn_s_waitcnt(0xc07f); __builtin_amdgcn_wave_barrier();
        const bool act = coop ? (c.wave == 0 && kq == 0 && i_ < 8) : (kq == 0);
        if (act) {
            float lg[4]; lg[0] = gl0 + p.in[I_BRG + c.z][l * 4 + 0]; lg[1] = gl1 + p.in[I_BRG + c.z][l * 4 + 1]; lg[2] = gl2 + p.in[I_BRG + c.z][l * 4 + 2]; lg[3] = gl3 + p.in[I_BRG + c.z][l * 4 + 3];
            int gsel = 0; float gm = lg[0];
#pragma unroll
            for (int j = 1; j < 4; ++j) if (lg[j] > gm) { gm = lg[j]; gsel = j; }
            float den = 0.f;
#pragma unroll
            for (int j = 0; j < 4; ++j) den += __expf(lg[j] - gm);
            const float gp = 1.f / den;
            float e[8];
#pragma unroll
            for (int i = 0; i < 8; ++i) e[i] = sc_l[i_ * 33 + gsel * 8 + i];
            int i1 = 0; float v1 = e[0];
#pragma unroll
            for (int i = 1; i < 8; ++i) if (e[i] > v1) { v1 = e[i]; i1 = i; }
            int i2 = -1; float v2 = -3.0e38f;
#pragma unroll
            for (int i = 0; i < 8; ++i) if (i != i1 && e[i] > v2) { v2 = e[i]; i2 = i; }
            const float ex = __expf(v2 - v1); const float p1 = 1.f / (1.f + ex), p2 = ex / (1.f + ex);
            e1 = gsel * 8 + i1; e2 = gsel * 8 + i2; g1v = p1 * gp; g2v = p2 * gp;
            sel_l[c.wave * 32 + 2 * i_] = e1; sel_l[c.wave * 32 + 2 * i_ + 1] = e2;
        }
        __syncthreads();
        if (c.tid < 32) { int n = 0;
#pragma unroll 1
            for (int q0 = 0; q0 < 256; q0 += 16) { int ev[16];
#pragma unroll
                for (int q = 0; q < 16; ++q) ev[q] = sel_l[q0 + q];
#pragma unroll
                for (int q = 0; q < 16; ++q) if (ev[q] == c.tid) { lrk_l[q0 + q] = n; ++n; } }
            int base = 0; if (n > 0) base = atomicAdd(cnt + c.tid, n);
            base_l[c.tid] = base; }
        __syncthreads();
        if (act) {
            const int r1 = base_l[e1] + lrk_l[c.wave * 32 + 2 * i_], r2 = base_l[e2] + lrk_l[c.wave * 32 + 2 * i_ + 1];
            list[(size_t)e1 * R + r1] = row * 2; list[(size_t)e2 * R + r2] = row * 2 + 1;
            { float* lg_ = (float*)(c.dout + DO_LGATE); lg_[(size_t)e1 * R + r1] = g1v; lg_[(size_t)e2 * R + r2] = g2v; }
            gate[row * 2] = g1v; gate[row * 2 + 1] = g2v;
        }
        __syncthreads();
    }
    __syncthreads();
}

#define BFP(off) ((const bf16_t*)(c->ws + (off)))
struct SInproj { const Ctx* c; pg8::TileOrder o;
    DEV bool next(int i, pg8::Unit& u) const { int pm, pn; if (!o.get(i, pm, pn)) return false;
        u.A = BFP(WS_XN) + (size_t)pm * 256 * 1024; u.Bt = BFP(c->wofs + W_IN) + (size_t)pn * 256 * 1024; u.lda = 1024; u.kstepA = 128; u.row0 = pm * 256; u.col0 = pn * 256; u.aux = 0; u.keep = 0; u.gl = nullptr; u.gn = 0; return true; } };
struct EInproj { const Ctx* c;
    DEV void operator()(f32x4 (&acc)[2][2][4][2], const pg8::Unit& u, int wr, int wc, int fr, int fq) const {
        const int which = (u.col0 == C_CQ) ? 0 : (u.col0 == C_CKV) ? 1 : -1;
        const bool rope = (u.row0 < RX) && (u.col0 < C_VA || u.col0 == C_KR);
#pragma unroll
        for (int ai = 0; ai < 2; ++ai)
#pragma unroll
        for (int mh = 0; mh < 2; ++mh) {
            f32x4 tb[2][2][2];
#pragma unroll
            for (int m2 = 0; m2 < 2; ++m2)
#pragma unroll
                for (int bj = 0; bj < 2; ++bj) { tb[m2][bj][0] = (f32x4){1.f, 0.f, 1.f, 0.f}; tb[m2][bj][1] = (f32x4){1.f, 0.f, 1.f, 0.f};
                    const int col0 = u.col0 + bj * 128 + wc * 32 + 8 * fq;
                    if (rope && (u.col0 != C_KA || bj == 0) && (u.col0 != C_KR || col0 < C_END)) { const f32x4* t = inproj_tab(*c, u.row0 + ai * 128 + wr * 64 + (mh * 2 + m2) * 16 + fr, col0); tb[m2][bj][0] = t[0]; tb[m2][bj][1] = t[1]; } }
#pragma unroll
            for (int m2 = 0; m2 < 2; ++m2) { const int m = mh * 2 + m2; const int row = u.row0 + ai * 128 + wr * 64 + m * 16 + fr; float ss = 0.f;
#pragma unroll
                for (int bj = 0; bj < 2; ++bj) { const int col0 = u.col0 + bj * 128 + wc * 32 + 8 * fq;
                    float v[8]; const f32x4 x0 = acc[ai][bj][m][0], x1 = acc[ai][bj][m][1];
                    v[0] = x0[0]; v[1] = x0[1]; v[2] = x0[2]; v[3] = x0[3]; v[4] = x1[0]; v[5] = x1[1]; v[6] = x1[2]; v[7] = x1[3];
                    epi_inproj(*c, row, col0, v, tb[m2][bj]);
#pragma unroll
                    for (int i = 0; i < 8; ++i) ss += v[i] * v[i]; }
                if (which >= 0) { ss += __shfl_xor(ss, 16); ss += __shfl_xor(ss, 32);
                    if (fq == 0) ((float*)(c->ws + WS_SSQ))[(size_t)(row * 2 + which) * 4 + wc] = ss; } }
            asm volatile("" ::: "memory"); } } };
struct SUp { const Ctx* c; pg8::TileOrder o;
    DEV bool next(int i, pg8::Unit& u) const { int pm, pn; if (!o.get(i, pm, pn)) return false;
        if (pn < 3) { u.A = BFP(WS_CQ) + (size_t)pm * 256 * 256; u.Bt = BFP(c->wofs + W_UQ) + (size_t)pn * 256 * 256; u.col0 = pn * 256; u.aux = 0; }
        else { u.A = BFP(WS_CKV) + (size_t)pm * 256 * 256; u.Bt = BFP(c->wofs + W_UKV) + (size_t)(pn - 3) * 256 * 256; u.col0 = (pn - 3) * 256; u.aux = 1; }
        u.lda = 256; u.kstepA = 128; u.row0 = pm * 256; u.keep = 0; u.gl = nullptr; u.gn = 0; return true; } };
struct EUp { const Ctx* c;
    DEV void operator()(f32x4 (&acc)[2][2][4][2], const pg8::Unit& u, int wr, int wc, int fr, int fq) const {
        float rs[2][4];
#pragma unroll
        for (int ai = 0; ai < 2; ++ai)
#pragma unroll
            for (int m = 0; m < 4; ++m) { const int row = u.row0 + ai * 128 + wr * 64 + m * 16 + fr;
                const f32x4 sq = *(const f32x4*)((const float*)(c->ws + WS_SSQ) + (size_t)(row * 2 + u.aux) * 4); rs[ai][m] = rsqrtf(((sq.x + sq.y) + (sq.z + sq.w)) * (1.f / 256.f) + EPS); }
#pragma unroll
        for (int ai = 0; ai < 2; ++ai) {
#pragma unroll
            for (int m = 0; m < 4; ++m) { const int row = u.row0 + ai * 128 + wr * 64 + m * 16 + fr;
#pragma unroll
                for (int bj = 0; bj < 2; ++bj) { const int col0 = u.col0 + bj * 128 + wc * 32 + 8 * fq;
                    float v[8]; const f32x4 x0 = acc[ai][bj][m][0], x1 = acc[ai][bj][m][1];
                    v[0] = x0[0]; v[1] = x0[1]; v[2] = x0[2]; v[3] = x0[3]; v[4] = x1[0]; v[5] = x1[1]; v[6] = x1[2]; v[7] = x1[3];
                    if (u.aux == 0) epi_upq(*c, row, col0, v, rs[ai][m] * SCALE_B); else epi_upkv(*c, row, col0, v, rs[ai][m]); } }
            asm volatile("" ::: "memory"); } } };
struct SBranch { const Ctx* c; pg8::TileOrder o;
    DEV bool next(int i, pg8::Unit& u) const { int pm, pn; const int pair = i / 3, br = i - pair * 3; if (!o.get(pair, pm, pn)) return false;
        if (br == 0) { u.A = BFP(WS_QA) + (size_t)pm * 256 * 512; u.lda = 512; u.kstepA = 128; u.Bt = BFP(c->wofs + W_BA) + (size_t)pn * 256 * 512; }
        else if (br == 1) { u.A = BFP(WS_QB) + (size_t)pm * 256 * 768; u.lda = 768; u.kstepA = 192; u.Bt = BFP(c->wofs + W_BB) + (size_t)pn * 256 * 512; }
        else { u.A = BFP(WS_POOL) + (size_t)pm * 256 * 512; u.lda = 512; u.kstepA = 128; u.Bt = BFP(c->wofs + W_BC) + (size_t)pn * 256 * 512; }
        u.row0 = pm * 256; u.col0 = pn * 256; u.aux = br; u.keep = (br < 2); u.gl = nullptr; u.gn = 0; return true; } };
DEV void gates_u8(const u32x2 w, float (&g)[8]) {
    g[0] = (float)(w.x & 255u); g[1] = (float)((w.x >> 8) & 255u); g[2] = (float)((w.x >> 16) & 255u); g[3] = (float)(w.x >> 24);
    g[4] = (float)(w.y & 255u); g[5] = (float)((w.y >> 8) & 255u); g[6] = (float)((w.y >> 16) & 255u); g[7] = (float)(w.y >> 24); }
struct EBranch { const Ctx* c;
    DEV void operator()(f32x4 (&acc)[2][2][4][2], const pg8::Unit& u, int wr, int wc, int fr, int fq) const {
        const unsigned char* G = c->dout + DO_G;
#pragma unroll
        for (int ai = 0; ai < 2; ++ai) {
            u32x2 ga[4][2], gb[4][2];
#pragma unroll
            for (int m = 0; m < 4; ++m)
#pragma unroll
                for (int bj = 0; bj < 2; ++bj) { const size_t off = (size_t)(u.row0 + ai * 128 + wr * 64 + m * 16 + fr) * 3072 + (u.col0 + bj * 128 + wc * 32 + 8 * fq);
                    ga[m][bj] = *(const u32x2*)(G + off + u.aux * 1024); gb[m][bj] = ga[m][bj]; if (u.aux < 2) gb[m][bj] = *(const u32x2*)(G + off + (u.aux + 1) * 1024); }
#pragma unroll
            for (int m = 0; m < 4; ++m) { const int row = u.row0 + ai * 128 + wr * 64 + m * 16 + fr;
#pragma unroll
                for (int bj = 0; bj < 2; ++bj) { const int col0 = u.col0 + bj * 128 + wc * 32 + 8 * fq;
                    float g0[8]; gates_u8(ga[m][bj], g0);
                    if (u.aux < 2) { float g1[8]; gates_u8(gb[m][bj], g1);
#pragma unroll
                        for (int i = 0; i < 4; ++i) { acc[ai][bj][m][0][i] *= g0[i] * __builtin_amdgcn_rcpf(g1[i]); acc[ai][bj][m][1][i] *= g0[4 + i] * __builtin_amdgcn_rcpf(g1[4 + i]); }
                    } else { float y[8];
#pragma unroll
                        for (int i = 0; i < 4; ++i) { y[i] = acc[ai][bj][m][0][i] * g0[i] * (1.f / 255.f); y[4 + i] = acc[ai][bj][m][1][i] * g0[4 + i] * (1.f / 255.f); }
                        *(u32x4*)((bf16_t*)(c->ws + WS_Y) + (size_t)row * 1024 + col0) = pack8(y); } } }
            asm volatile("" ::: "memory"); } } };
struct SOut { const Ctx* c; pg8::TileOrder o;
    DEV bool next(int i, pg8::Unit& u) const { int pm, pn; if (!o.get(i, pm, pn)) return false;
        u.A = BFP(WS_Y) + (size_t)pm * 256 * 1024; u.Bt = BFP(c->wofs + W_OUT) + (size_t)pn * 256 * 1024; u.lda = 1024; u.kstepA = 128; u.row0 = pm * 256; u.col0 = pn * 256; u.aux = 0; u.keep = 0; u.gl = nullptr; u.gn = 0; return true; } };
template <int L> struct EOut { const Ctx* c;
    DEV void operator()(f32x4 (&acc)[2][2][4][2], const pg8::Unit& u, int wr, int wc, int fr, int fq) const {
        const float* basef = (u.row0 < RX ? c->p->in[I_X + c->z] + (size_t)u.row0 * DM : c->p->in[I_CTX + c->z] + (size_t)(u.row0 - RX) * DM) + u.col0;
        bf16_t* Hp = (bf16_t*)(c->ws + WS_H) + (size_t)u.row0 * DM + u.col0;
        const float* g1p = modp(c->ws, L, mod_idx(u.row0), 2) + u.col0 + wc * 32 + 8 * fq;
        f32x4 g[2][2];
#pragma unroll
        for (int bj = 0; bj < 2; ++bj) { g[bj][0] = *(const f32x4*)(g1p + bj * 128); g[bj][1] = *(const f32x4*)(g1p + bj * 128 + 4); }
        const int cl = wc * 32 + 8 * fq;
#pragma unroll
        for (int ai = 0; ai < 2; ++ai) { constexpr int mh = 0;
            u32x4 bq[4][2][2];
#pragma unroll
            for (int m2 = 0; m2 < 4; ++m2)
#pragma unroll
                for (int bj = 0; bj < 2; ++bj) { const unsigned off = (unsigned)((ai * 128 + wr * 64 + (mh * 2 + m2) * 16 + fr) * DM + cl + bj * 128);
                    if (L == 0) { bq[m2][bj][0] = *(const u32x4*)(basef + off); bq[m2][bj][1] = *(const u32x4*)(basef + off + 4); } else bq[m2][bj][0] = *(const u32x4*)(Hp + off); }
#pragma unroll
            for (int m2 = 0; m2 < 4; ++m2) { const int m = mh * 2 + m2; const int lr = ai * 128 + wr * 64 + m * 16 + fr; float ss = 0.f;
#pragma unroll
                for (int bj = 0; bj < 2; ++bj) { f32x4 b0, b1;
                    if (L == 0) { b0 = __builtin_bit_cast(f32x4, bq[m2][bj][0]); b1 = __builtin_bit_cast(f32x4, bq[m2][bj][1]); }
                    else { float t[8]; unpack8(bq[m2][bj][0], t); b0 = (f32x4){t[0], t[1], t[2], t[3]}; b1 = (f32x4){t[4], t[5], t[6], t[7]}; }
                    const f32x4 o0 = b0 + g[bj][0] * acc[ai][bj][m][0], o1 = b1 + g[bj][1] * acc[ai][bj][m][1];
                    u32x4 w; w.x = pk2(o0.x, o0.y); w.y = pk2(o0.z, o0.w); w.z = pk2(o1.x, o1.y); w.w = pk2(o1.z, o1.w);
                    *(u32x4*)(Hp + (unsigned)(lr * DM + cl + bj * 128)) = w;
                    ss += ((o0.x * o0.x + o0.y * o0.y) + (o0.z * o0.z + o0.w * o0.w)) + ((o1.x * o1.x + o1.y * o1.y) + (o1.z * o1.z + o1.w * o1.w)); }
                ss += __shfl_xor(ss, 16); ss += __shfl_xor(ss, 32);
                if (fq == 0) ((float*)(c->dout + DO_SSQH) + (size_t)u.row0 * 16 + (u.col0 >> 8) * 4)[(unsigned)(lr * 16 + wc)] = ss; }
            asm volatile("" ::: "memory"); } } };
constexpr int LDS_TT = 128 * 1024;
DEV void build_tile_table(const Ctx& c, const int* cnt) {
    int* tt = (int*)(c.lds + LDS_TT);
    for (int t = c.tid; t <= MAXTILES; t += 512) { int acc_t = 0, v = -1;
        for (int e = 0; e < NEXP; ++e) { const int nte = (cnt[e] + 255) >> 8; if (v < 0 && t < acc_t + nte) v = (e << 16) | (t - acc_t); acc_t += nte; }
        tt[t] = v; }
    __syncthreads();
}
template <int NPN> struct SMoe { const Ctx* c; const int* cnt; int G, cid;
    DEV bool next(int i, pg8::Unit& u) const {
        const int L = i * G + cid, tile = L / NPN, pn = L - tile * NPN;
        if (tile >= MAXTILES) return false;
        const int v = __builtin_amdgcn_readfirstlane(((const int*)(c->lds + LDS_TT))[tile]);
        if (v < 0) return false;
        const int e = v >> 16, j = v & 0xffff; const int ce = cnt[e];
        u.gl = (const int*)(c->ws + WS_LIST) + (size_t)e * R + j * 256; u.gn = min(256, ce - j * 256); u.keep = 0; u.aux = e; u.kstepA = 128;
        if (NPN == 2) { u.A = BFP(WS_FX); u.lda = 1024; u.Bt = BFP(c->wofs + W_GU) + ((size_t)e * 512 + pn * 256) * 1024; u.row0 = tile * 256; u.col0 = pn * 128; }
        else { u.A = BFP(WS_H1) + (size_t)tile * 256 * 256; u.lda = 256; u.Bt = BFP(c->wofs + W_DN) + ((size_t)e * 1024 + pn * 256) * 256; u.row0 = 0; u.col0 = pn * 256; }
        return true; } };
struct EMoe1 { const Ctx* c;
    DEV void operator()(f32x4 (&acc)[2][2][4][2], const pg8::Unit& u, int wr, int wc, int fr, int fq) const {
#pragma unroll
        for (int ai = 0; ai < 2; ++ai)
#pragma unroll
            for (int m = 0; m < 4; ++m) { const int slot = u.row0 + ai * 128 + wr * 64 + m * 16 + fr; const int col = u.col0 + wc * 32 + 8 * fq; float h[8];
#pragma unroll
                for (int i = 0; i < 4; ++i) { const float g0 = acc[ai][0][m][0][i], g1 = acc[ai][0][m][1][i];
                    h[i] = g0 * sigmoid_fast(g0) * acc[ai][1][m][0][i]; h[4 + i] = g1 * sigmoid_fast(g1) * acc[ai][1][m][1][i]; }
                *(u32x4*)((bf16_t*)(c->ws + WS_H1) + (size_t)slot * 256 + col) = pack8(h); } } };
struct EMoe2 { const Ctx* c;
    DEV void operator()(f32x4 (&acc)[2][2][4][2], const pg8::Unit& u, int wr, int wc, int fr, int fq) const {
        int tk[2][4]; float gt[2][4];
        const float* lgp = (const float*)(c->dout + DO_LGATE) + (u.gl - (const int*)(c->ws + WS_LIST));
#pragma unroll
        for (int ai = 0; ai < 2; ++ai)
#pragma unroll
            for (int m = 0; m < 4; ++m) { const int lr = ai * 128 + wr * 64 + m * 16 + fr; const bool ok = lr < u.gn; tk[ai][m] = ok ? u.gl[lr] : -1; gt[ai][m] = ok ? lgp[lr] : 0.f; }
#pragma unroll
        for (int ai = 0; ai < 2; ++ai)
#pragma unroll
            for (int m = 0; m < 4; ++m) { if (tk[ai][m] >= 0) {
#pragma unroll
                for (int bj = 0; bj < 2; ++bj) { const int col0 = u.col0 + bj * 128 + wc * 32 + 8 * fq; float y[8];
#pragma unroll
                    for (int i = 0; i < 4; ++i) { y[i] = acc[ai][bj][m][0][i] * gt[ai][m]; y[4 + i] = acc[ai][bj][m][1][i] * gt[ai][m]; }
                    *(u32x4*)((bf16_t*)(c->ws + WS_YTOK) + (size_t)tk[ai][m] * 1024 + col0) = pack8(y); } } } } };

#define LAS __attribute__((address_space(3)))
#define XB_TMO      128
#define XB_XCNT(j)  (256  + 64 * (j))
#define XB_XSUB(j)  (1280 + 64 * (j))
#define XB_XGEN(j)  (2304 + 64 * (j))
#define XB_TOP      3328
#define XB_TOPGEN   3392
#define XCD_BAR_WORDS 3456
#define XB_SPIN_CAP (1u << 18)
DEV unsigned xb_ld(unsigned* p)              { return __hip_atomic_load(p, __ATOMIC_RELAXED, __HIP_MEMORY_SCOPE_AGENT); }
DEV unsigned xb_add(unsigned* p, unsigned v) { return __hip_atomic_fetch_add(p, v, __ATOMIC_RELAXED, __HIP_MEMORY_SCOPE_AGENT); }
DEV unsigned xb_xcc_id() { return (unsigned)__builtin_amdgcn_s_getreg((3 << 11) | 20) & 0xFu; }
#define XB_SPIN(cond, bar) do { unsigned _sp = 0; while (cond) { __builtin_amdgcn_s_sleep(1); \
    if ((++_sp & 255u) == 0u) { if (xb_ld(&(bar)[XB_TMO])) break; if (_sp > XB_SPIN_CAP) { atomicAdd(&(bar)[XB_TMO], 1u); break; } } } } while (0)
struct XcdBarrier { unsigned* bar; unsigned x; volatile LAS unsigned* st; };
DEV XcdBarrier xcd_barrier_post(unsigned* bar, volatile LAS unsigned* st) {
    XcdBarrier b; b.bar = bar; b.x = xb_xcc_id(); b.st = st;
    if (threadIdx.x == 0) (void)xb_add(&bar[XB_XCNT(b.x)], 1u);
    return b;
}
DEV void xcd_barrier_complete(unsigned* bar, unsigned x, unsigned& nloc, unsigned& nx) {
    const unsigned G = gridDim.x * gridDim.y * gridDim.z;
    unsigned sum, cnt, mine, sp = 0u;
    for (;;) {
        sum = 0u; cnt = 0u; mine = 0u;
#pragma unroll
        for (unsigned j = 0; j < 16; ++j) { const unsigned c = xb_ld(&bar[XB_XCNT(j)]); sum += c; cnt += (c > 0u) ? 1u : 0u; mine = (j == x) ? c : mine; }
        if (sum == G) break;
        __builtin_amdgcn_s_sleep(1);
        if ((++sp & 255u) == 0u) { if (xb_ld(&bar[XB_TMO])) break; if (sp > XB_SPIN_CAP) { atomicAdd(&bar[XB_TMO], 1u); break; } }
    }
    nloc = mine > 0u ? mine : 1u; nx = cnt > 0u ? cnt : 1u;
}
DEV void xcd_barrier(const XcdBarrier& b) {
    asm volatile("s_waitcnt vmcnt(0)" ::: "memory");
    __syncthreads();
    if (threadIdx.x == 0) {
        unsigned* bar = b.bar;
        __builtin_amdgcn_s_waitcnt(0);
        unsigned nloc = b.st[0], nx = b.st[1];
        if (nloc == 0u) { xcd_barrier_complete(bar, b.x, nloc, nx); b.st[0] = nloc; b.st[1] = nx; }
        const unsigned old = xb_add(&bar[XB_XSUB(b.x)], 1u);
        const unsigned gen = old / nloc;
        if (old + 1u == (gen + 1u) * nloc) {
            __builtin_amdgcn_fence(__ATOMIC_RELEASE, "agent");
            asm volatile("s_waitcnt vmcnt(0)" ::: "memory");
            const unsigned og = xb_add(&bar[XB_TOP], 1u);
            const unsigned tg = og / nx;
            if (og + 1u == (tg + 1u) * nx) xb_add(&bar[XB_TOPGEN], 1u);
            else XB_SPIN(xb_ld(&bar[XB_TOPGEN]) == tg, bar);
            __builtin_amdgcn_fence(__ATOMIC_ACQUIRE, "agent");
            xb_add(&bar[XB_XGEN(b.x)], 1u);
            asm volatile("s_waitcnt vmcnt(0)" ::: "memory");
        } else {
            XB_SPIN(xb_ld(&bar[XB_XGEN(b.x)]) == gen, bar);
            __builtin_amdgcn_fence(__ATOMIC_ACQUIRE, "agent");
            asm volatile("s_waitcnt vmcnt(0)" ::: "memory");
        }
    }
    __syncthreads();
}

constexpr int STEPS = 9, NPROG = 1 + DEPTH * STEPS + 1;
constexpr int LDS_BARST = 131 * 1024;
DEV Ctx make_ctx(const Params& p, unsigned char* lds) {
    typedef __attribute__((address_space(1))) unsigned char gchar_t;
    gchar_t* ws_ = (gchar_t*)p.ws; gchar_t* do_ = (gchar_t*)p.out; int z_ = 0; int tid_ = threadIdx.x;
    asm volatile("" : "+s"(ws_), "+s"(do_), "+s"(z_)); asm volatile("" : "+v"(tid_));
    Ctx c; c.p = &p; c.z = z_; c.dummy = 0; c.wofs = WS_W; c.wre = WS_WRE; c.ws = (unsigned char*)ws_; c.dout = (unsigned char*)do_; c.lds = lds;
    c.tid = tid_; c.lane = c.tid & 63; c.wave = __builtin_amdgcn_readfirstlane(c.tid >> 6); c.G = gridDim.x + z_; c.gw = blockIdx.x * 8 + c.wave; c.NGW = c.G * 8; c.gtid = blockIdx.x * 512 + c.tid; c.NT = c.G * 512;
    return c;
}
DEV void tail_convert(const Ctx& c, int l, int part) {
    if (l != 0 || DEPTH < 2) return;
    const int nbusy = (R / 256) * 4 - 2 * c.G;
    if (nbusy <= 0 || nbusy >= c.G || 3 * c.G < (R / 256) * 4) { if (part == 1) { convert_weights(c, 1, (int)blockIdx.x, c.G, 0); convert_weights(c, 1, (int)blockIdx.x, c.G, 1); } return; }
    if ((int)blockIdx.x >= nbusy) convert_weights(c, 1, (int)blockIdx.x - nbusy, c.G - nbusy, part);
}
DEV void run_step(const Ctx& c0, int l, int s) {
    Ctx c = c0; c.wofs = (l == 0) ? WS_W : WS_W1; c.wre = WS_WRE + (size_t)l * 131072;
    const bool last = (l == DEPTH - 1); const int nrows = last ? RX : R;
    PG8_LAS unsigned char* L3 = (PG8_LAS unsigned char*)c.lds;
    if (s == 0) phase_rows(c, l, false);
    else if (s == 1) { SInproj S{&c}; S.o.init(R / 256, NIN / 256, c.G, (int)blockIdx.x); EInproj E{&c}; pg8::gemm_phase<EInproj, SInproj, false>(L3, 1024, S, E); }
    else if (s == 2) { SUp S{&c}; S.o.init(R / 256, 7, c.G, (int)blockIdx.x); EUp E{&c}; pg8::gemm_phase<EUp, SUp, false>(L3, 256, S, E); }
    else if (s == 3) phase_attn_fast(c, l);
    else if (s == 4) { SBranch S{&c}; S.o.init(nrows / 256, 4, c.G, (int)blockIdx.x); EBranch E{&c}; pg8::gemm_phase<EBranch, SBranch, false>(L3, 512, S, E); tail_convert(c, l, 0); }
    else if (s == 5) { SOut S{&c}; S.o.init(nrows / 256, 4, c.G, (int)blockIdx.x); if (l == 0) { EOut<0> E{&c}; pg8::gemm_phase<EOut<0>, SOut, false>(L3, 1024, S, E); } else { EOut<1> E{&c}; pg8::gemm_phase<EOut<1>, SOut, false>(L3, 1024, S, E); } tail_convert(c, l, 1); }
    else if (s == 6) phase_router(c, l);
    else if (s == 7) { const int* cnt = (const int*)(c.ws + WS_CNT) + l * 32; build_tile_table(c, cnt); SMoe<2> S{&c, cnt, c.G, (int)blockIdx.x}; EMoe1 E{&c}; pg8::gemm_phase<EMoe1, SMoe<2>, true>(L3, 1024, S, E); }
    else { const int* cnt = (const int*)(c.ws + WS_CNT) + l * 32; build_tile_table(c, cnt); SMoe<4> S{&c, cnt, c.G, (int)blockIdx.x}; EMoe2 E{&c}; pg8::gemm_phase<EMoe2, SMoe<4>, false>(L3, 256, S, E); }
}
#define SEAM(k) do { if ((k) + 1 < p.ph_hi) { XcdBarrier xb_; xb_.bar = (unsigned*)(p.ws + WS_BAR); xb_.x = xb_xcc_id(); xb_.st = (volatile LAS unsigned*)((LAS unsigned char*)lds + LDS_BARST); xcd_barrier(xb_); } } while (0)
#define STEP(k, body) do { if (p.ph_lo <= (k) && (k) < p.ph_hi) { { const Ctx c = make_ctx(p, lds); body; } SEAM(k); } } while (0)
template <int L> DEV void layer_steps(const Params& p, cg::grid_group& grid, unsigned char* lds) {
    STEP(1 + L * STEPS + 0, run_step(c, L, 0));
    STEP(1 + L * STEPS + 1, run_step(c, L, 1));
    STEP(1 + L * STEPS + 2, run_step(c, L, 2));
    STEP(1 + L * STEPS + 3, run_step(c, L, 3));
    STEP(1 + L * STEPS + 4, run_step(c, L, 4));
    STEP(1 + L * STEPS + 5, run_step(c, L, 5));
    STEP(1 + L * STEPS + 6, run_step(c, L, 6));
    STEP(1 + L * STEPS + 7, run_step(c, L, 7));
    STEP(1 + L * STEPS + 8, run_step(c, L, 8));
}
__global__ void __launch_bounds__(512, 2) mk(Params p) {
    extern __shared__ __attribute__((aligned(16))) unsigned char lds[];
    cg::grid_group grid = cg::this_grid();
    volatile LAS unsigned* st = (volatile LAS unsigned*)((LAS unsigned char*)lds + LDS_BARST);
    if (threadIdx.x < 2) st[threadIdx.x] = 0u;
    __syncthreads();
    (void)xcd_barrier_post((unsigned*)(p.ws + WS_BAR), st);
    grid.sync();
    STEP(0, { phase_p0(c); convert_weights(c, 0, (int)blockIdx.x, c.G, -1); });
    layer_steps<0>(p, grid, lds);
    layer_steps<1>(p, grid, lds);
    STEP(NPROG - 1, phase_rows(c, DEPTH, true));
}

constexpr int LDS_BYTES = 132 * 1024;
extern "C" void kernel_launch(void* const* d_in, const int* in_sizes, int n_in, void* d_out, int out_size, void* d_ws, size_t ws_size, hipStream_t stream) {
    static int grid = 0;
    if (grid == 0) {
        if (n_in != 27 || out_size != RX * DM || ws_size < WS_NEED) { fprintf(stderr, "kernel_launch: unexpected shapes n_in %d out %d ws %zu\n", n_in, out_size, ws_size); grid = -1; return; }
        int dev = 0, cus = 0, per_cu = 0;
        hipGetDevice(&dev); hipDeviceGetAttribute(&cus, hipDeviceAttributeMultiprocessorCount, dev);
        hipFuncSetAttribute((const void*)mk, hipFuncAttributeMaxDynamicSharedMemorySize, LDS_BYTES);
        hipOccupancyMaxActiveBlocksPerMultiprocessor(&per_cu, (const void*)mk, 512, LDS_BYTES);
        if (per_cu < 1) { fprintf(stderr, "kernel_launch: occupancy query says %d\n", per_cu); grid = -1; return; }
        grid = cus;
    }
    if (grid < 0) return;
    Params p{};
    for (int i = 0; i < 27; ++i) p.in[i] = (const float*)d_in[i];
    p.out = (float*)d_out; p.ws = (unsigned char*)d_ws;
    if (hipMemsetAsync((unsigned char*)d_ws + WS_BAR, 0, XCD_BAR_WORDS * 4, stream) != hipSuccess) { fprintf(stderr, "kernel_launch: memset failed\n"); return; }
    p.ph_lo = 0; p.ph_hi = NPROG;
    void* args[] = {&p};
    hipError_t e = hipLaunchCooperativeKernel((const void*)mk, dim3(grid), dim3(512), args, LDS_BYTES, stream);
    if (e != hipSuccess) fprintf(stderr, "cooperative launch failed: %s\n", hipGetErrorString(e));
}
```

```cpp
#include <hip/hip_runtime.h>
#include <hip/hip_cooperative_groups.h>
#include <cstdio>
#include <cstdint>
namespace cg = cooperative_groups;

#ifndef MK_ONE_LAUNCH
#define MK_ONE_LAUNCH 1
#endif

#define DEV __device__ __forceinline__
typedef unsigned short bf16_t;
typedef unsigned u32x4 __attribute__((ext_vector_type(4)));
typedef unsigned u32x2 __attribute__((ext_vector_type(2)));
typedef float f32x4 __attribute__((ext_vector_type(4)));

constexpr int DM = 1024, NB = 8, SEQ = 4096, LC = 256, DEPTH = 2;
constexpr int RX = NB * SEQ, RC = NB * LC, R = RX + RC;
constexpr int NIN = 5120;
constexpr int NEXP = 32, EFF = 256;
constexpr int MAXTILES = 304;
constexpr float EPS = 1e-6f;
constexpr float LOG2E = 1.4426950408889634f;
constexpr float SCALE_A = 0.125f * LOG2E;
constexpr float SCALE_B = 0.10206207261596577f * LOG2E;

constexpr int C_QA = 0, C_KA = 512, C_VA = 640, C_CQ = 768, C_CKV = 1024, C_U = 1280, C_G = 1792, C_KR = 4864, C_END = 4896;

constexpr size_t MiB = 1ull << 20;
constexpr size_t WS_MOD = 0;
constexpr size_t WS_TABA = 448 * 1024;
constexpr size_t WS_TABB = 460 * 1024;
constexpr size_t WS_CNT = 512 * 1024;
constexpr size_t WS_WRE = 1 * MiB;
constexpr size_t WS_BAR = 576 * 1024;
constexpr size_t WS_SSQ = 6 * MiB + 512 * 1024;
constexpr size_t WS_GATE = 1 * MiB + 512 * 1024;
constexpr size_t WS_LIST = 2 * MiB;
constexpr size_t WS_W = 8 * MiB;
constexpr size_t WS_W1 = 140 * MiB;
constexpr size_t W_IN = 0, W_UQ = W_IN + (size_t)NIN * 1024 * 2, W_UKV = W_UQ + 768 * 256 * 2, W_BA = W_UKV + 1024 * 256 * 2,
                 W_BB = W_BA + 1024 * 512 * 2, W_BC = W_BB + 1024 * 512 * 2, W_OUT = W_BC + 1024 * 512 * 2,
                 W_GU = W_OUT + 1024 * 1024 * 2, W_DN = W_GU + (size_t)NEXP * 512 * 1024 * 2, W_TOTAL = W_DN + (size_t)NEXP * 1024 * 256 * 2;
static_assert(W_TOTAL <= 64 * MiB, "weights");
constexpr size_t WS_H = 72 * MiB;
constexpr size_t WS_XN = 208 * MiB;
constexpr size_t WS_QA = 276 * MiB;
constexpr size_t WS_QB = 310 * MiB;
constexpr size_t WS_KNB = 361 * MiB;
constexpr size_t WS_VB = 395 * MiB;
constexpr size_t WS_CQ = 429 * MiB;
constexpr size_t WS_CKV = 446 * MiB;
constexpr size_t WS_POOL = 429 * MiB;
constexpr size_t WS_U = 463 * MiB;
constexpr size_t WS_YTOK = 310 * MiB;
constexpr size_t WS_H1 = 446 * MiB;
constexpr size_t WS_Y = 361 * MiB;
constexpr size_t WS_FX = 361 * MiB;
constexpr size_t WS_NEED = 512 * MiB;
constexpr size_t DO_G = 0;
constexpr size_t DO_KA = (size_t)R * 3072;
constexpr size_t DO_VA = DO_KA + (size_t)R * 128 * 2;
constexpr size_t DO_KR = DO_VA + (size_t)R * 128 * 2;
constexpr size_t DO_SSQH = DO_KR + (size_t)R * 32 * 2;
constexpr size_t DO_LGATE = DO_SSQH + (size_t)R * 16 * 4;
static_assert(DO_LGATE + (size_t)NEXP * R * 4 <= (size_t)RX * DM * 4, "d_out scratch");

struct Params { const float* in[27]; float* out; unsigned char* ws; int ph_lo, ph_hi; };
enum { I_X = 0, I_C, I_CTX, I_CCTX, I_WMOD, I_BMOD, I_GMIX, I_GFFN, I_WIN, I_SINK, I_QNG, I_WUQ, I_KVNG, I_WUKV, I_WPOOL, I_PSCALE,
       I_WBA, I_WBB, I_WBC, I_WOUT, I_WRG, I_BRG, I_WRE, I_BRE, I_WGU, I_WDN, I_FING };

DEV float bf2f(bf16_t v) { return __uint_as_float((unsigned)v << 16); }
DEV unsigned f2bf(float f) { unsigned u = __float_as_uint(f); return (u + 0x7fffu + ((u >> 16) & 1u)) >> 16; }
DEV unsigned pk2(float lo, float hi) { unsigned r; asm("v_cvt_pk_bf16_f32 %0, %1, %2" : "=v"(r) : "v"(lo), "v"(hi)); return r; }
DEV void unpack8(const u32x4 w, float (&f)[8]) {
    f[0] = __uint_as_float(w.x << 16); f[1] = __uint_as_float(w.x & 0xffff0000u); f[2] = __uint_as_float(w.y << 16); f[3] = __uint_as_float(w.y & 0xffff0000u);
    f[4] = __uint_as_float(w.z << 16); f[5] = __uint_as_float(w.z & 0xffff0000u); f[6] = __uint_as_float(w.w << 16); f[7] = __uint_as_float(w.w & 0xffff0000u);
}
DEV u32x4 pack8(const float (&f)[8]) { u32x4 w; w.x = pk2(f[0], f[1]); w.y = pk2(f[2], f[3]); w.z = pk2(f[4], f[5]); w.w = pk2(f[6], f[7]); return w; }
DEV float wave_sum(float v) {
#pragma unroll
    for (int o = 1; o < 64; o <<= 1) v += __shfl_xor(v, o);
    return v;
}
DEV float sigmoidf_(float x) { return 1.f / (1.f + __expf(-x)); }
DEV float sigmoid_fast(float x) { return __builtin_amdgcn_rcpf(1.f + __builtin_amdgcn_exp2f(x * (-LOG2E))); }
DEV int mod_idx(int row) { return row < RX ? (row >> 12) : 8; }
DEV const float* modp(const unsigned char* ws, int l, int mb, int chunk) { return (const float*)(ws + WS_MOD) + ((size_t)(l * 9 + mb) * 6 + chunk) * 1024; }

struct Ctx {
    const Params* p; unsigned char* ws; unsigned char* dout; unsigned char* lds; int z; int dummy; size_t wofs, wre;
    int tid, lane, wave, G, gw, NGW, gtid, NT;
};

DEV void epi_inproj(const Ctx& c, int row, int col0, const float (&vin)[8], const f32x4 (&tb)[2]) {
    float v[8];
#pragma unroll
    for (int i = 0; i < 8; ++i) v[i] = vin[i];
    const bool xrow = row < RX;
    if (col0 < C_VA) {
        const bool isq = col0 < C_KA;
        const int w0 = col0 & 63;
        if (xrow) {
#pragma unroll
            for (int i = 0; i < 4; ++i) { const float cx = tb[i >> 1][2 * (i & 1)], sx = tb[i >> 1][2 * (i & 1) + 1]; const float a = v[2 * i], b = v[2 * i + 1]; v[2 * i] = a * cx - b * sx; v[2 * i + 1] = a * sx + b * cx; }
        }
        if (isq) {
#pragma unroll
            for (int i = 0; i < 8; ++i) v[i] *= SCALE_A;
            *(u32x4*)((bf16_t*)(c.ws + WS_QA) + (size_t)row * 512 + col0) = pack8(v);
        } else *(u32x4*)((bf16_t*)(c.dout + DO_KA) + (size_t)row * 128 + (col0 - C_KA)) = pack8(v);
    } else if (col0 < C_CQ) {
        *(u32x4*)((bf16_t*)(c.dout + DO_VA) + (size_t)row * 128 + (col0 - C_VA)) = pack8(v);
    } else if (col0 < C_CKV) {
        *(u32x4*)((bf16_t*)(c.ws + WS_CQ) + (size_t)row * 256 + (col0 - C_CQ)) = pack8(v);
    } else if (col0 < C_U) {
        *(u32x4*)((bf16_t*)(c.ws + WS_CKV) + (size_t)row * 256 + (col0 - C_CKV)) = pack8(v);
    } else if (col0 < C_G) {
        *(u32x4*)((bf16_t*)(c.ws + WS_U) + (size_t)row * 512 + (col0 - C_U)) = pack8(v);
    } else if (col0 < C_KR) {
        unsigned q[8];
#pragma unroll
        for (int i = 0; i < 8; ++i) { const float s = __builtin_amdgcn_rcpf(1.f + __builtin_amdgcn_exp2f(v[i] * (-LOG2E))) * 255.f + 0.5f; q[i] = max((unsigned)s, 1u); }
        u32x2 w; w.x = q[0] | (q[1] << 8) | (q[2] << 16) | (q[3] << 24); w.y = q[4] | (q[5] << 8) | (q[6] << 16) | (q[7] << 24);
        *(u32x2*)(c.dout + DO_G + (size_t)row * 3072 + (col0 - C_G)) = w;
    } else if (col0 < C_END) {
        const int w0 = col0 - C_KR;
        if (xrow) {
#pragma unroll
            for (int i = 0; i < 4; ++i) { const float cx = tb[i >> 1][2 * (i & 1)], sx = tb[i >> 1][2 * (i & 1) + 1]; const float a = v[2 * i], b = v[2 * i + 1]; v[2 * i] = a * cx - b * sx; v[2 * i + 1] = a * sx + b * cx; }
        }
        *(u32x4*)((bf16_t*)(c.dout + DO_KR) + (size_t)row * 32 + w0) = pack8(v);
    }
}
DEV const f32x4* inproj_tab(const Ctx& c, int row, int col0) {
    const int pos = row & (SEQ - 1);
    if (col0 < C_VA) { const int p0 = (col0 & 63) >> 1; const int pp = (p0 < 16) ? (pos >> 6) : (pos & 63); return (const f32x4*)((const float2*)(c.ws + WS_TABA) + pp * 16 + (p0 & 15)); }
    const int p0 = (col0 - C_KR) >> 1; const int pp = (p0 < 8) ? (pos >> 6) : (pos & 63); return (const f32x4*)((const float2*)(c.ws + WS_TABB) + pp * 8 + (p0 & 7));
}
DEV void epi_upq(const Ctx& c, int row, int col0, const float (&vin)[8], float rs) {
    float v[8];
#pragma unroll
    for (int i = 0; i < 8; ++i) v[i] = vin[i] * rs;
    const int w0 = col0 % 96;
    if (w0 >= 64 && row < RX) {
        const int pos = row & (SEQ - 1); const int p0 = (w0 - 64) >> 1; const int pp = (p0 < 8) ? (pos >> 6) : (pos & 63);
        const float2* tab = (const float2*)(c.ws + WS_TABB) + pp * 8 + (p0 & 7);
#pragma unroll
        for (int i = 0; i < 4; ++i) { const float2 cs = tab[i]; const float a = v[2 * i], b = v[2 * i + 1]; v[2 * i] = a * cs.x - b * cs.y; v[2 * i + 1] = a * cs.y + b * cs.x; }
    }
    *(u32x4*)((bf16_t*)(c.ws + WS_QB) + (size_t)row * 768 + col0) = pack8(v);
}
DEV void epi_upkv(const Ctx& c, int row, int col0, const float (&vin)[8], float rs) {
    float v[8];
#pragma unroll
    for (int i = 0; i < 8; ++i) v[i] = vin[i] * rs;
    const int h = col0 >> 7, w0 = col0 & 127;
    if (w0 < 64) *(u32x4*)((bf16_t*)(c.ws + WS_KNB) + (size_t)row * 512 + h * 64 + w0) = pack8(v);
    else *(u32x4*)((bf16_t*)(c.ws + WS_VB) + (size_t)row * 512 + h * 64 + (w0 - 64)) = pack8(v);
}
DEV void load_gates8(const Ctx& c, int row, int col, float (&g)[8]) {
    const u32x2 w = *(const u32x2*)(c.dout + DO_G + (size_t)row * 3072 + col);
    g[0] = (float)(w.x & 255u); g[1] = (float)((w.x >> 8) & 255u); g[2] = (float)((w.x >> 16) & 255u); g[3] = (float)(w.x >> 24);
    g[4] = (float)(w.y & 255u); g[5] = (float)((w.y >> 8) & 255u); g[6] = (float)((w.y >> 16) & 255u); g[7] = (float)(w.y >> 24);
}
namespace pg8 {
#define PG8_LAS __attribute__((address_space(3)))
typedef short bf16x8 __attribute__((ext_vector_type(8)));
constexpr int BM = 256, BK = 64, HALF = 128, HTB = HALF * BK * 2, STAGE_BYTES = 8 * HTB, NXCD = 8, WGM = 8;
DEV int lds_byte(int r, int c) { const int st = (r >> 4) * 2 + (c >> 5), rr = r & 15, cc = c & 31, ob = rr * 64 + cc * 2; return st * 1024 + (ob ^ (((ob >> 9) & 1) << 5)); }
DEV void stage_rc(int b, int& R_, int& C_) { const int st = b / 1024, sb = b % 1024, swz = sb ^ (((sb >> 9) & 1) << 5); R_ = (st >> 1) * 16 + swz / 64; C_ = (st & 1) * 32 + (swz % 64) / 2; }
DEV int perm32(int rho) { const int n = rho >> 4, i = rho & 15; return 8 * (i >> 2) + 4 * n + (i & 3); }

struct Unit { const bf16_t* A; const bf16_t* Bt; int lda; int kstepA; int row0, col0; int aux; int keep; const int* gl; int gn; };

struct TileOrder { int nM, nN, nwg, G, c;
    DEV void init(int nM_, int nN_, int G_, int c_) { nM = nM_; nN = nN_; nwg = nM * nN; G = G_; c = c_; }
    DEV bool get(int i, int& pm, int& pn) const {
        const long L = (long)i * G + c; if (L >= nwg) return false;
        int wgid = (int)L; { const int q = nwg / NXCD, r = nwg % NXCD, xcd = wgid % NXCD, off = wgid / NXCD; wgid = (xcd < r ? xcd * (q + 1) : r * (q + 1) + (xcd - r) * q) + off; }
        const int nig = WGM * nN, gid = wgid / nig, fm = gid * WGM, gsz = (nM - fm) < WGM ? (nM - fm) : WGM;
        pm = fm + ((wgid % nig) % gsz); pn = (wgid % nig) / gsz; return true; } };

template <bool GATHER>
DEV void calc_voA(const Unit& u, unsigned (&vo)[2][2], const int (&Rr)[2], const int (&Cc)[2]) {
#pragma unroll
    for (int h = 0; h < 2; ++h)
#pragma unroll
        for (int i = 0; i < 2; ++i) { const int r = h * HALF + Rr[i]; int srow = r;
            if (GATHER) srow = (r < u.gn) ? (u.gl[r] >> 1) : 0;
            vo[h][i] = (unsigned)(srow * u.lda + Cc[i]) * 2u; }
}

template <class Epi, class Sched, bool GATHER>
DEV void gemm_phase(PG8_LAS unsigned char* lds, const int K, const Sched& S, const Epi& E) {
    const int tid = threadIdx.x, wid = __builtin_amdgcn_readfirstlane(tid >> 6), lane = tid & 63, wr = wid >> 2, wc = wid & 3, fr = lane & 15, fq = lane >> 4;
    const int nt = K / BK;
    int Rr[2], Cc[2]; unsigned voffB[2];
#pragma unroll
    for (int i = 0; i < 2; ++i) { stage_rc(tid * 16 + i * 8192, Rr[i], Cc[i]); const int Rb = (Rr[i] & ~31) + perm32(Rr[i] & 31); voffB[i] = (unsigned)(Rb * K + Cc[i]) * 2u; }
    const size_t kstep = (size_t)(BK * 2);
    const size_t hstepB = (size_t)HALF * K * 2;
    const unsigned ldsw = (unsigned)wid * 1024u;
    const int aoff = lds_byte(wr * 64 + fr, fq * 8), boff = lds_byte(wc * 32 + fr, fq * 8);
#define PG8_SA(b, h) (((b) * 2 + (h)) * HTB)
#define PG8_SB(b, h) ((4 + (b) * 2 + (h)) * HTB)
#define PG8_STAGE(bufoff, gbase, voff) do { _Pragma("unroll") for (int _i = 0; _i < 2; ++_i) \
        __builtin_amdgcn_global_load_lds((const unsigned*)((const char*)(gbase) + (voff)[_i]), (PG8_LAS unsigned*)(lds + (bufoff) + ldsw + _i * 8192), 16, 0, 0); } while (0)
#define PG8_STAGE_A(bufoff, gbase, h, lda_, vo_) do { _Pragma("unroll") for (int _i = 0; _i < 2; ++_i) { \
        const unsigned _o = GATHER ? (vo_)[h][_i] : (unsigned)(((h) * HALF + Rr[_i]) * (lda_) + Cc[_i]) * 2u; \
        __builtin_amdgcn_global_load_lds((const unsigned*)((const char*)(gbase) + _o), (PG8_LAS unsigned*)(lds + (bufoff) + ldsw + _i * 8192), 16, 0, 0); } } while (0)
#define PG8_LDA(dst, b, h) do { _Pragma("unroll") for (int m = 0; m < 4; ++m) _Pragma("unroll") for (int k = 0; k < 2; ++k) dst[m][k] = *(const PG8_LAS bf16x8*)(lds + PG8_SA(b, h) + aoff + m * 2048 + k * 1024); } while (0)
#define PG8_LDB(dst, b, h) do { _Pragma("unroll") for (int n = 0; n < 2; ++n) _Pragma("unroll") for (int k = 0; k < 2; ++k) dst[n][k] = *(const PG8_LAS bf16x8*)(lds + PG8_SB(b, h) + boff + n * 2048 + k * 1024); } while (0)
#define PG8_MMA(ai, bj, At, Bt) do { __builtin_amdgcn_s_setprio(1); _Pragma("unroll") for (int m = 0; m < 4; ++m) _Pragma("unroll") for (int n = 0; n < 2; ++n) _Pragma("unroll") for (int k = 0; k < 2; ++k) \
        acc[ai][bj][m][n] = __builtin_amdgcn_mfma_f32_16x16x32_bf16(Bt[n][k], At[m][k], acc[ai][bj][m][n], 0, 0, 0); __builtin_amdgcn_s_setprio(0); } while (0)
#define PG8_WAIT_V(n) asm volatile("s_waitcnt vmcnt(" #n ")" ::: "memory")
#define PG8_WAIT_L(n) asm volatile("s_waitcnt lgkmcnt(" #n ")" ::: "memory")
#define PG8_BAR __builtin_amdgcn_s_barrier()
#define PG8_SCHED __builtin_amdgcn_sched_barrier(0)
    Unit cur, nxt; int ui = 0;
    if (!S.next(0, cur)) return;
    f32x4 acc[2][2][4][2];
#pragma unroll
    for (int a = 0; a < 2; ++a)
#pragma unroll
        for (int b = 0; b < 2; ++b)
#pragma unroll
            for (int m = 0; m < 4; ++m)
#pragma unroll
                for (int n = 0; n < 2; ++n) acc[a][b][m][n] = (f32x4){0.f, 0.f, 0.f, 0.f};
    bf16x8 At[4][2], B0[2][2], B1[2][2];
    unsigned voA[2][2], nvoA[2][2];
    if (GATHER) calc_voA<GATHER>(cur, voA, Rr, Cc);
    const char* cA = (const char*)cur.A; const char* cB = (const char*)cur.Bt;
    PG8_STAGE(PG8_SB(0, 0), cB, voffB); PG8_STAGE(PG8_SB(0, 1), cB + hstepB, voffB); PG8_STAGE_A(PG8_SA(0, 0), cA, 0, cur.lda, voA); PG8_STAGE_A(PG8_SA(0, 1), cA, 1, cur.lda, voA);
    if (wr == 1) PG8_BAR;
    PG8_WAIT_V(2); PG8_BAR;
    PG8_STAGE(PG8_SB(1, 0), cB + kstep, voffB); PG8_STAGE_A(PG8_SA(1, 0), cA + cur.kstepA, 0, cur.lda, voA); PG8_STAGE(PG8_SB(1, 1), cB + hstepB + kstep, voffB);
    PG8_WAIT_V(6); PG8_BAR;
    for (;;) {
        const bool has_next = S.next(ui + 1, nxt);
        const char* nA = has_next ? (const char*)nxt.A : cA; const char* nB = has_next ? (const char*)nxt.Bt : cB;
        if (GATHER && has_next) calc_voA<GATHER>(nxt, nvoA, Rr, Cc);
        else if (GATHER) {
#pragma unroll
            for (int h = 0; h < 2; ++h)
#pragma unroll
                for (int i = 0; i < 2; ++i) nvoA[h][i] = voA[h][i]; }
#pragma unroll 1
        for (int t = 0; t < nt; t += 2) {
            const bool last = (t == nt - 2);
            const char* a1 = cA + (size_t)(t + 1) * cur.kstepA;
            const char* a2 = last ? nA : cA + (size_t)(t + 2) * cur.kstepA; const char* b2 = last ? nB : cB + (size_t)(t + 2) * kstep;
            const char* a3 = a2 + ((last && has_next) ? nxt.kstepA : cur.kstepA); const char* b3 = b2 + kstep;
            unsigned v2[2][2]; const int lda2 = (last && has_next) ? nxt.lda : cur.lda;
            if (GATHER) {
#pragma unroll
                for (int h = 0; h < 2; ++h)
#pragma unroll
                    for (int i = 0; i < 2; ++i) v2[h][i] = last ? nvoA[h][i] : voA[h][i]; }
            PG8_LDB(B0, 0, 0); PG8_LDB(B1, 0, 1); PG8_SCHED; PG8_LDA(At, 0, 0); PG8_STAGE_A(PG8_SA(1, 1), a1, 1, cur.lda, voA);
            PG8_WAIT_V(8); PG8_WAIT_L(0); PG8_BAR; PG8_MMA(0, 0, At, B0); PG8_MMA(0, 1, At, B1); PG8_BAR; PG8_SCHED;
            PG8_LDA(At, 0, 1); PG8_STAGE(PG8_SB(0, 0), b2, voffB); PG8_STAGE(PG8_SB(0, 1), b2 + hstepB, voffB); PG8_STAGE_A(PG8_SA(0, 0), a2, 0, lda2, v2);
            PG8_WAIT_V(8); PG8_WAIT_L(0); PG8_BAR; PG8_MMA(1, 0, At, B0); PG8_MMA(1, 1, At, B1); PG8_BAR; PG8_SCHED;
            PG8_LDB(B0, 1, 0); PG8_LDB(B1, 1, 1); PG8_SCHED; PG8_LDA(At, 1, 0); PG8_STAGE_A(PG8_SA(0, 1), a2, 1, lda2, v2);
            PG8_WAIT_V(8); PG8_WAIT_L(0); PG8_BAR; PG8_MMA(0, 0, At, B0); PG8_MMA(0, 1, At, B1); PG8_BAR; PG8_SCHED;
            PG8_LDA(At, 1, 1); PG8_STAGE(PG8_SB(1, 0), b3, voffB); PG8_STAGE(PG8_SB(1, 1), b3 + hstepB, voffB); PG8_STAGE_A(PG8_SA(1, 0), a3, 0, lda2, v2);
            PG8_WAIT_V(8); PG8_WAIT_L(0); PG8_BAR; PG8_MMA(1, 0, At, B0); PG8_MMA(1, 1, At, B1); PG8_BAR; PG8_SCHED;
        }
        if (wr == 0) PG8_BAR;
        { int fr_ = fr, fq_ = fq, wr_ = wr, wc_ = wc;
          asm volatile("" : "+v"(fr_), "+v"(fq_)); asm volatile("" : "+s"(wr_), "+s"(wc_));
          E(acc, cur, wr_, wc_, fr_, fq_); }
        if (!has_next) break;
        if (!cur.keep) {
#pragma unroll
            for (int a = 0; a < 2; ++a)
#pragma unroll
                for (int b = 0; b < 2; ++b)
#pragma unroll
                    for (int m = 0; m < 4; ++m)
#pragma unroll
                        for (int n = 0; n < 2; ++n) acc[a][b][m][n] = (f32x4){0.f, 0.f, 0.f, 0.f}; }
        cur = nxt; cA = nA; cB = nB; ++ui;
        if (GATHER) {
#pragma unroll
            for (int h = 0; h < 2; ++h)
#pragma unroll
                for (int i = 0; i < 2; ++i) voA[h][i] = nvoA[h][i]; }
        if (wr == 1) PG8_BAR;
    }
    PG8_WAIT_V(0);
    PG8_BAR;
#undef PG8_SA
#undef PG8_SB
#undef PG8_STAGE
#undef PG8_STAGE_A
#undef PG8_LDA
#undef PG8_LDB
#undef PG8_MMA
#undef PG8_WAIT_V
#undef PG8_WAIT_L
#undef PG8_BAR
#undef PG8_SCHED
}
template <class F> struct Epi8 { F f;
    DEV void operator()(f32x4 (&acc)[2][2][4][2], const Unit& u, int wr, int wc, int fr, int fq) const {
#pragma unroll
        for (int ai = 0; ai < 2; ++ai)
#pragma unroll
            for (int m = 0; m < 4; ++m) { const int row = u.row0 + ai * HALF + wr * 64 + m * 16 + fr;
#pragma unroll
                for (int bj = 0; bj < 2; ++bj) { const int col0 = u.col0 + bj * HALF + wc * 32 + 8 * fq;
                    float v[8]; const f32x4 x0 = acc[ai][bj][m][0], x1 = acc[ai][bj][m][1];
                    v[0] = x0[0]; v[1] = x0[1]; v[2] = x0[2]; v[3] = x0[3]; v[4] = x1[0]; v[5] = x1[1]; v[6] = x1[2]; v[7] = x1[3];
                    f(u, row, col0, v); asm volatile("" ::: "memory"); } } } };
}

DEV void phase_p0(const Ctx& c) {
    const Params& p = *c.p;
    if (blockIdx.x == 0 && c.tid < 64) ((int*)(c.ws + WS_CNT))[c.tid] = 0;
    if (c.gtid < 64 * 16) { const int pos = c.gtid >> 4, i = c.gtid & 15; const float inv = powf(10000.f, -(float)(2 * i) / 32.f); const float ang = (float)pos * inv;
        ((float2*)(c.ws + WS_TABA))[c.gtid] = make_float2(cosf(ang), sinf(ang)); }
    else if (c.gtid < 64 * 16 + 64 * 8) { const int g = c.gtid - 1024; const int pos = g >> 3, i = g & 7; const float inv = powf(10000.f, -(float)(2 * i) / 16.f); const float ang = (float)pos * inv;
        ((float2*)(c.ws + WS_TABB))[g] = make_float2(cosf(ang), sinf(ang)); }
    float* sc = (float*)c.lds;
    float* red = sc + 9 * 1024;
    for (int i = c.tid; i < 9 * 1024; i += 512) { const float v = (i < 8 * 1024) ? p.in[I_C + c.z][i] : p.in[I_CCTX + c.z][i - 8 * 1024]; sc[i] = v * sigmoidf_(v); }
    __syncthreads();
    for (int item = blockIdx.x; item < 256; item += c.G) {
        const int l = item / 128, nb = item % 128, n = nb * 48 + (c.lane < 48 ? c.lane : 47);
        const float* W = p.in[I_WMOD + c.z] + (size_t)l * 1024 * 6144 + n;
        float acc[9];
#pragma unroll
        for (int j = 0; j < 9; ++j) acc[j] = 0.f;
#pragma unroll 1
        for (int k0 = c.wave * 128; k0 < c.wave * 128 + 128; k0 += 32) { float w[32];
#pragma unroll
            for (int i = 0; i < 32; ++i) w[i] = W[(size_t)(k0 + i) * 6144];
#pragma unroll
            for (int i = 0; i < 32; ++i)
#pragma unroll
                for (int j = 0; j < 9; ++j) acc[j] += sc[j * 1024 + k0 + i] * w[i]; }
#pragma unroll
        for (int j = 0; j < 9; ++j) red[(c.wave * 9 + j) * 64 + c.lane] = acc[j];
        __syncthreads();
        for (int i = c.tid; i < 576; i += 512) { const int j = i >> 6, ln = i & 63; float s = 0.f;
#pragma unroll
            for (int w = 0; w < 8; ++w) s += red[(w * 9 + j) * 64 + ln];
            if (ln < 48) ((float*)(c.ws + WS_MOD))[(size_t)(l * 9 + j) * 6144 + nb * 48 + ln] = s + p.in[I_BMOD + c.z][l * 6144 + nb * 48 + ln]; }
        __syncthreads();
    }
}

DEV void tr_item(const float* W, int ldn, int K, int k0, int nsrc0, bf16_t* WT, int d0, float* scr, int lane, const float* kscale, bool zero) {
#pragma unroll 8
    for (int i = 0; i < 32; ++i) { const int kk = 2 * i + (lane >> 5); float v = 0.f;
        if (!zero) { v = W[(size_t)(k0 + kk) * ldn + nsrc0 + (lane & 31)]; if (kscale) v *= kscale[k0 + kk]; }
        scr[kk * 33 + (lane & 31)] = v; }
    __builtin_amdgcn_s_waitcnt(0xc07f); __builtin_amdgcn_wave_barrier();
    const int ch = lane & 7;
#pragma unroll
    for (int j = 0; j < 4; ++j) { const int n = (lane >> 3) + 8 * j; const float* s = scr + (8 * ch) * 33 + n;
        u32x4 o; o.x = pk2(s[0], s[33]); o.y = pk2(s[2 * 33], s[3 * 33]); o.z = pk2(s[4 * 33], s[5 * 33]); o.w = pk2(s[6 * 33], s[7 * 33]);
        *(u32x4*)(WT + (size_t)(d0 + n) * K + k0 + 8 * ch) = o; }
    __builtin_amdgcn_s_waitcnt(0xc07f); __builtin_amdgcn_wave_barrier();
}
constexpr int CV_IN = 8 * 20, CV_UQ = 2 * 3, CV_UKV = 2 * 4, CV_BR = 4 * 4, CV_OUT = 8 * 4, CV_GU = NEXP * 8 * 2, CV_DN = NEXP * 2 * 4;
constexpr int CV_NITEMS = CV_IN + CV_UQ + CV_UKV + 2 * CV_BR + CV_OUT + CV_GU + CV_DN, CV_SPLIT = 600;
DEV void tr_wg_item(const Ctx& c, const float* W, int ldn, int K, int k0, int d0, int kind, bf16_t* WT, const float* kscale) {
    float* tile = (float*)c.lds;
    const int r8 = c.tid >> 6, c4 = (c.tid & 63) * 4;
    const int dblk = d0 + (c4 & ~31); int sblk;
    if (kind == 1) sblk = (dblk < C_U) ? dblk : (dblk < C_KR) ? dblk + 32 : (dblk < C_END) ? dblk - C_KR + 1280 : -1;
    else if (kind == 2) { const int pn = dblk >> 8, w = dblk & 255; sblk = (w < 128) ? (128 * pn + w) : (256 + 128 * pn + (w - 128)); }
    else sblk = dblk;
    f32x4 v[16];
#pragma unroll
    for (int it = 0; it < 16; ++it) { const int kk = it * 8 + r8; v[it] = (f32x4){0.f, 0.f, 0.f, 0.f};
        if (sblk >= 0) v[it] = *(const f32x4*)(W + (size_t)(k0 + kk) * ldn + sblk + (c4 & 31)); }
    __syncthreads();
#pragma unroll
    for (int it = 0; it < 16; ++it) { const int kk = it * 8 + r8; f32x4 t = v[it]; if (kscale) t = t * kscale[k0 + kk];
        float* d = tile + kk * 257 + c4; d[0] = t.x; d[1] = t.y; d[2] = t.z; d[3] = t.w; }
    __syncthreads();
#pragma unroll
    for (int j = 0; j < 8; ++j) { const int idx = j * 512 + c.tid, ch = idx & 15, n = idx >> 4; const float* sp = tile + (ch * 8) * 257 + n;
        u32x4 o; o.x = pk2(sp[0], sp[257]); o.y = pk2(sp[2 * 257], sp[3 * 257]); o.z = pk2(sp[4 * 257], sp[5 * 257]); o.w = pk2(sp[6 * 257], sp[7 * 257]);
        *(u32x4*)(WT + (size_t)(d0 + n) * K + k0 + 8 * ch) = o; }
}
DEV void convert_weights(const Ctx& c, int l, int wi, int nw, int part) {
    const Params& p = *c.p; unsigned char* wb = c.ws + (l == 0 ? WS_W : WS_W1); float* wre = (float*)(c.ws + WS_WRE + (size_t)l * 131072);
    const int it_lo = (part == 1) ? CV_SPLIT : 0, it_hi = (part == 0) ? CV_SPLIT : CV_NITEMS;
    const int gtid_ = wi * 512 + c.tid, nt_ = nw * 512;
    for (int it = it_lo + wi; it < it_hi; it += nw) {
        int r = it;
        if (r < CV_IN) { tr_wg_item(c, p.in[I_WIN + c.z] + (size_t)l * 1024 * 4896, 4896, 1024, (r / 20) * 128, (r % 20) * 256, 1, (bf16_t*)(wb + W_IN), nullptr); continue; } r -= CV_IN;
        if (r < CV_UQ) { tr_wg_item(c, p.in[I_WUQ + c.z] + (size_t)l * 256 * 768, 768, 256, (r / 3) * 128, (r % 3) * 256, 0, (bf16_t*)(wb + W_UQ), p.in[I_QNG + c.z] + l * 256); continue; } r -= CV_UQ;
        if (r < CV_UKV) { tr_wg_item(c, p.in[I_WUKV + c.z] + (size_t)l * 256 * 1024, 1024, 256, (r / 4) * 128, (r % 4) * 256, 0, (bf16_t*)(wb + W_UKV), p.in[I_KVNG + c.z] + l * 256); continue; } r -= CV_UKV;
        if (r < CV_BR) { tr_wg_item(c, p.in[I_WBA + c.z] + (size_t)l * 512 * 1024, 1024, 512, (r / 4) * 128, (r % 4) * 256, 0, (bf16_t*)(wb + W_BA), nullptr); continue; } r -= CV_BR;
        if (r < CV_BR) { tr_wg_item(c, p.in[I_WBB + c.z] + (size_t)l * 512 * 1024, 1024, 512, (r / 4) * 128, (r % 4) * 256, 0, (bf16_t*)(wb + W_BB), nullptr); continue; } r -= CV_BR;
        if (r < CV_OUT) { tr_wg_item(c, p.in[I_WOUT + c.z] + (size_t)l * 1024 * 1024, 1024, 1024, (r / 4) * 128, (r % 4) * 256, 0, (bf16_t*)(wb + W_OUT), nullptr); continue; } r -= CV_OUT;
        if (r < CV_GU) { const int e = r / 16, q = r % 16; tr_wg_item(c, p.in[I_WGU + c.z] + ((size_t)l * NEXP + e) * 1024 * 512, 512, 1024, (q / 2) * 128, (q % 2) * 256, 2, (bf16_t*)(wb + W_GU) + (size_t)e * 512 * 1024, nullptr); continue; } r -= CV_GU;
        { const int e = r / 8, q = r % 8; tr_wg_item(c, p.in[I_WDN + c.z] + ((size_t)l * NEXP + e) * 256 * 1024, 1024, 256, (q / 4) * 128, (q % 4) * 256, 0, (bf16_t*)(wb + W_DN) + (size_t)e * 1024 * 256, nullptr); }
    }
    __syncthreads();
    if (part == 1) return;
    for (int i = gtid_; i < 1024 * 32; i += nt_) { const int u8 = i & 7, j16 = (i >> 3) & 15, kq = (i >> 7) & 3, half = (i >> 9) & 1, cc2 = i >> 10;
        wre[i] = p.in[I_WRE + c.z][(size_t)l * 1024 * 32 + (size_t)(32 * cc2 + 8 * kq + u8) * 32 + 16 * half + j16]; }
    const float* wp = p.in[I_WPOOL + c.z] + (size_t)l * 4 * 128 * 128; const float* ps = p.in[I_PSCALE + c.z] + l * 512; const float* wc = p.in[I_WBC + c.z] + (size_t)l * 512 * 1024;
    for (int item = gtid_; item < 64 * 1024; item += nt_) {
        const int kg = item >> 10, n = item & 1023, g = kg >> 4, i0 = (kg & 15) * 8;
        float acc[8];
#pragma unroll
        for (int i = 0; i < 8; ++i) acc[i] = 0.f;
        for (int j = 0; j < 128; ++j) { const float b = ps[128 * g + j] * wc[(size_t)(128 * g + j) * 1024 + n];
#pragma unroll
            for (int i = 0; i < 8; ++i) acc[i] += wp[(size_t)(g * 128 + i0 + i) * 128 + j] * b; }
        *(u32x4*)((bf16_t*)(wb + W_BC) + (size_t)n * 512 + kg * 8) = pack8(acc);
    }
}

struct RowRaw { f32x4 x[4]; u32x2 h[4], y0[4], y1[4]; };
DEV void rows_fetch(const Ctx& c, int l, int r, RowRaw& q) {
    if (l == 0) { const float* src = (r < RX) ? c.p->in[I_X + c.z] + (size_t)r * DM : c.p->in[I_CTX + c.z] + (size_t)(r - RX) * DM;
#pragma unroll
        for (int j = 0; j < 4; ++j) q.x[j] = *(const f32x4*)(src + 4 * c.lane + 256 * j);
    } else { const bf16_t* H = (const bf16_t*)(c.ws + WS_H) + (size_t)r * DM; const bf16_t* Y = (const bf16_t*)(c.ws + WS_YTOK) + (size_t)r * 2048;
#pragma unroll
        for (int j = 0; j < 4; ++j) { const int col = 4 * c.lane + 256 * j; q.h[j] = *(const u32x2*)(H + col); q.y0[j] = *(const u32x2*)(Y + col); q.y1[j] = *(const u32x2*)(Y + 1024 + col); } }
}
struct RowPar { f32x4 gm[4], sh[4], sc[4], g2[4]; int mb; };
DEV void rows_finish(const Ctx& c, int l, bool final_, int r, const RowRaw& q, RowPar& P) {
    const int mb = mod_idx(r);
    if (mb != P.mb) { P.mb = mb;
#pragma unroll
        for (int j = 0; j < 4; ++j) { const int col = 4 * c.lane + 256 * j;
            if (l > 0) P.g2[j] = *(const f32x4*)(modp(c.ws, l - 1, mb, 5) + col);
            if (!final_) { P.sh[j] = *(const f32x4*)(modp(c.ws, l, mb, 0) + col); const f32x4 t = *(const f32x4*)(modp(c.ws, l, mb, 1) + col); P.sc[j] = P.gm[j] * (1.f + t); } } }
    f32x4 v[4];
#pragma unroll
    for (int j = 0; j < 4; ++j) {
        if (l == 0) v[j] = q.x[j];
        else { f32x4 o; const u32x2 hb = q.h[j], y0 = q.y0[j], y1 = q.y1[j]; const f32x4 g = P.g2[j];
            o.x = __uint_as_float(hb.x << 16) + g.x * (__uint_as_float(y0.x << 16) + __uint_as_float(y1.x << 16));
            o.y = __uint_as_float(hb.x & 0xffff0000u) + g.y * (__uint_as_float(y0.x & 0xffff0000u) + __uint_as_float(y1.x & 0xffff0000u));
            o.z = __uint_as_float(hb.y << 16) + g.z * (__uint_as_float(y0.y << 16) + __uint_as_float(y1.y << 16));
            o.w = __uint_as_float(hb.y & 0xffff0000u) + g.w * (__uint_as_float(y0.y & 0xffff0000u) + __uint_as_float(y1.y & 0xffff0000u));
            v[j] = o;
            if (!final_) { u32x2 w; w.x = pk2(o.x, o.y); w.y = pk2(o.z, o.w); *(u32x2*)((bf16_t*)(c.ws + WS_H) + (size_t)r * DM + 4 * c.lane + 256 * j) = w; } } }
    float s = 0.f;
#pragma unroll
    for (int j = 0; j < 4; ++j) s += (v[j].x * v[j].x + v[j].y * v[j].y) + (v[j].z * v[j].z + v[j].w * v[j].w);
    const float rstd = rsqrtf(wave_sum(s) * (1.f / DM) + EPS);
    if (final_) { float* o = (float*)c.dout + (size_t)r * DM;
#pragma unroll
        for (int j = 0; j < 4; ++j) *(f32x4*)(o + 4 * c.lane + 256 * j) = v[j] * rstd * P.gm[j];
    } else { bf16_t* xn = (bf16_t*)(c.ws + WS_XN) + (size_t)r * DM;
#pragma unroll
        for (int j = 0; j < 4; ++j) { const f32x4 t = v[j] * rstd * P.sc[j] + P.sh[j]; u32x2 w; w.x = pk2(t.x, t.y); w.y = pk2(t.z, t.w); *(u32x2*)(xn + 4 * c.lane + 256 * j) = w; } }
}
DEV void phase_rows(const Ctx& c, int l, bool final_) {
    const int nrows = final_ ? RX : R;
    const int r_lo = (int)(((long)c.gw * nrows) / c.NGW), r_hi = (int)(((long)(c.gw + 1) * nrows) / c.NGW);
    RowPar P; P.mb = -1;
    { const float* g = final_ ? c.p->in[I_FING + c.z] : c.p->in[I_GMIX + c.z] + l * DM;
#pragma unroll
      for (int j = 0; j < 4; ++j) P.gm[j] = *(const f32x4*)(g + 4 * c.lane + 256 * j); }
    if (r_lo >= r_hi) return;
    RowRaw A, B;
    rows_fetch(c, l, r_lo, A);
#pragma unroll 1
    for (int r = r_lo; r < r_hi; r += 2) {
        if (r + 1 < r_hi) rows_fetch(c, l, r + 1, B);
        rows_finish(c, l, final_, r, A, P);
        if (r + 1 < r_hi) { if (r + 2 < r_hi) rows_fetch(c, l, r + 2, A); rows_finish(c, l, final_, r + 1, B, P); }
    }
}

template <int RAD> DEV void pool_item(const Ctx& c, int g, int row) {
    const int col = g * 128 + ((int)threadIdx.x & 15) * 8;
    int base, t, L;
    if (row < RX) { base = row & ~(SEQ - 1); t = row & (SEQ - 1); L = SEQ; } else { base = RX + ((row - RX) & ~(LC - 1)); t = (row - RX) & (LC - 1); L = LC; }
    const bf16_t* U = (const bf16_t*)(c.ws + WS_U);
    u32x4 w[2 * RAD + 1];
#pragma unroll
    for (int d = -RAD; d <= RAD; ++d) { int j = t + d; j = j < 0 ? 0 : j; j = j > L - 1 ? L - 1 : j; w[d + RAD] = *(const u32x4*)(U + (size_t)(base + j) * 512 + col); }
    float s[8];
#pragma unroll
    for (int i = 0; i < 8; ++i) s[i] = 0.f;
#pragma unroll
    for (int d = -RAD; d <= RAD; ++d) { const int j = t + d; float tv[8]; unpack8(w[d + RAD], tv); const float ok = (j >= 0 && j < L) ? 1.f : 0.f;
#pragma unroll
        for (int i = 0; i < 8; ++i) s[i] += ok * tv[i]; }
    float me[8]; unpack8(w[RAD], me);
    int lo = t - RAD, hi = t + RAD + 1; if (lo < 0) lo = 0; if (hi > L) hi = L;
    const float invn = 1.f / (float)(hi - lo);
#pragma unroll
    for (int i = 0; i < 8; ++i) s[i] = s[i] * invn - me[i];
    *(u32x4*)((bf16_t*)(c.ws + WS_POOL) + (size_t)row * 512 + col) = pack8(s);
}
DEV void phase_pool(const Ctx& c, int nrows) {
    const int nq = nrows / 4;
    const int tid_ = threadIdx.x, gw_ = (int)blockIdx.x * 8 + (tid_ >> 6);
    for (int it = gw_; it < 4 * nq; it += c.NGW) {
        const int g = it / nq, row = (it - g * nq) * 4 + ((tid_ & 63) >> 4);
        if (g == 0) pool_item<1>(c, 0, row); else if (g == 1) pool_item<2>(c, 1, row); else if (g == 2) pool_item<4>(c, 2, row); else pool_item<8>(c, 3, row);
    }
}

namespace fa {
using bf16x8 = __attribute__((ext_vector_type(8))) short;
using s16x4 = __attribute__((ext_vector_type(4))) short;
using f32x16 = __attribute__((ext_vector_type(16))) float;
#define FA_SBAR() __builtin_amdgcn_sched_barrier(0)
constexpr float THR = 8.f;
DEV int crow(int r, int hi) { return (r & 3) + 8 * (r >> 2) + 4 * hi; }
typedef __bf16 bf16x2_t __attribute__((ext_vector_type(2))); typedef float f32x2_t __attribute__((ext_vector_type(2)));
DEV unsigned cvtpk(float lo, float hi) { const f32x2_t v = {lo, hi}; const bf16x2_t b = __builtin_convertvector(v, bf16x2_t); return __builtin_bit_cast(unsigned, b); }
DEV int v_st(int k, int col) { const int kk = (k & ~0xC) | ((k & 4) << 1) | ((k & 8) >> 1); return ((kk >> 3) * 2 + (col >> 5)) * 512 + ((kk & 7) * 32 + (col & 31)) * 2; }
DEV int v_rd_base(int lane) { return ((lane & 3) << 3) | (((lane >> 2) & 3) << 6) | (((lane >> 4) & 1) << 5) | (((lane >> 5) & 1) << 8); }
constexpr int v_rd_off(int d0, int ks, int half) { return d0 * 512 + ks * 2048 + half * 1024; }
template <int OFF> DEV s16x4 tr_read(int vb) { s16x4 r; asm volatile("ds_read_b64_tr_b16 %0, %1 offset:%2" : "=&v"(r) : "v"(vb), "i"(OFF) : "memory"); return r; }
template <int D0> DEV void pv_one(f32x16& od, int vb, bf16x8 pa0, bf16x8 pa1, bf16x8 pa2, bf16x8 pa3) {
    const s16x4 l0 = tr_read<v_rd_off(D0, 0, 0)>(vb), h0 = tr_read<v_rd_off(D0, 0, 1)>(vb), l1 = tr_read<v_rd_off(D0, 1, 0)>(vb), h1 = tr_read<v_rd_off(D0, 1, 1)>(vb);
    const s16x4 l2 = tr_read<v_rd_off(D0, 2, 0)>(vb), h2 = tr_read<v_rd_off(D0, 2, 1)>(vb), l3 = tr_read<v_rd_off(D0, 3, 0)>(vb), h3 = tr_read<v_rd_off(D0, 3, 1)>(vb);
    asm volatile("s_waitcnt lgkmcnt(0)" ::: "memory"); FA_SBAR();
#define FA_PK(L, H) (bf16x8){L[0], L[1], L[2], L[3], H[0], H[1], H[2], H[3]}
    od = __builtin_amdgcn_mfma_f32_32x32x16_bf16(pa0, FA_PK(l0, h0), od, 0, 0, 0);
    od = __builtin_amdgcn_mfma_f32_32x32x16_bf16(pa1, FA_PK(l1, h1), od, 0, 0, 0);
    od = __builtin_amdgcn_mfma_f32_32x32x16_bf16(pa2, FA_PK(l2, h2), od, 0, 0, 0);
    od = __builtin_amdgcn_mfma_f32_32x32x16_bf16(pa3, FA_PK(l3, h3), od, 0, 0, 0);
#undef FA_PK
}
DEV float max3f(float a, float b, float c) { float r; asm volatile("v_max3_f32 %0, %1, %2, %3" : "=v"(r) : "v"(a), "v"(b), "v"(c)); return r; }
DEV float max2f(float a, float b) { float r; asm volatile("v_max_f32_e32 %0, %1, %2" : "=v"(r) : "v"(a), "v"(b)); return r; }
DEV float halfmax32(const f32x16& p0, const f32x16& p1) {
    float a = __builtin_fmaxf(__builtin_fmaxf(p0[0], p0[1]), p1[0]), b = __builtin_fmaxf(__builtin_fmaxf(p0[2], p0[3]), p1[1]); a = __builtin_fmaxf(__builtin_fmaxf(a, p1[2]), p1[3]);
#pragma unroll
    for (int r = 4; r < 16; r += 4) { a = __builtin_fmaxf(__builtin_fmaxf(a, p0[r]), p0[r + 1]); b = __builtin_fmaxf(__builtin_fmaxf(b, p0[r + 2]), p0[r + 3]);
        a = __builtin_fmaxf(__builtin_fmaxf(a, p1[r]), p1[r + 1]); b = __builtin_fmaxf(__builtin_fmaxf(b, p1[r + 2]), p1[r + 3]); }
    return __builtin_fmaxf(a, b);
}
DEV float mergehalves_max(float m) { auto rr = __builtin_amdgcn_permlane32_swap(__float_as_uint(m), __float_as_uint(m), false, false); return __builtin_fmaxf(__uint_as_float(rr[0]), __uint_as_float(rr[1])); }
template <bool FIRST>
DEV void partialSM(f32x16& p0, f32x16& p1, float& m_reg, f32x16& negm, float& alpha) {
    const float hm = halfmax32(p0, p1);
    alpha = 1.f;
    if (FIRST || __builtin_expect(__any(hm > THR), 0)) {
        const float pm = mergehalves_max(hm);
        const float dl = FIRST ? pm : __builtin_fmaxf(pm, 0.f); m_reg += dl;
#pragma unroll
        for (int r = 0; r < 16; ++r) { p0[r] -= dl; p1[r] -= dl; }
#pragma unroll
        for (int r = 0; r < 16; ++r) negm[r] = -m_reg;
        asm volatile("" : "+v"(negm));
        if (!FIRST) alpha = __builtin_amdgcn_exp2f(-dl);
    }
#pragma unroll
    for (int r = 0; r < 16; ++r) p0[r] = __builtin_amdgcn_exp2f(p0[r]);
}
DEV void finishSM(f32x16& p0, f32x16& p1, float alpha, float& l_reg, bf16x8& pa0, bf16x8& pa1, bf16x8& pa2, bf16x8& pa3) {
#pragma unroll
    for (int r = 0; r < 16; ++r) p1[r] = __builtin_amdgcn_exp2f(p1[r]);
    float ps = p0[0] + p0[1];
#pragma unroll
    for (int r = 2; r < 16; ++r) ps += p0[r];
#pragma unroll
    for (int r = 0; r < 16; ++r) ps += p1[r];
    asm volatile("" : "+v"(ps));
    l_reg = l_reg * alpha + ps;
#define FA_PK4(P, BASE, OUT) do { unsigned a0 = cvtpk(P[BASE + 0], P[BASE + 1]), a1 = cvtpk(P[BASE + 2], P[BASE + 3]); \
    unsigned b0 = cvtpk(P[BASE + 4], P[BASE + 5]), b1 = cvtpk(P[BASE + 6], P[BASE + 7]); \
    u32x4 w = {a0, a1, b0, b1}; OUT = *reinterpret_cast<bf16x8*>(&w); } while (0)
    FA_PK4(p0, 0, pa0); FA_PK4(p0, 8, pa1); FA_PK4(p1, 0, pa2); FA_PK4(p1, 8, pa3);
#undef FA_PK4
}
DEV void glds16(const void* gsrc, unsigned lds_dst) { unsigned keep;
    asm volatile("s_mov_b32 %0, m0\n\ts_mov_b32 m0, %2\n\ts_nop 0\n\tglobal_load_lds_dwordx4 %1, off\n\ts_mov_b32 m0, %0" : "=&s"(keep) : "v"(gsrc), "s"(lds_dst) : "memory"); }
DEV void glds16x3(const void* g0, unsigned d0, const void* g1, unsigned d1, const void* g2, unsigned d2) { unsigned keep;
    asm volatile("s_mov_b32 %0, m0\n\ts_mov_b32 m0, %4\n\ts_nop 0\n\tglobal_load_lds_dwordx4 %1, off\n\ts_mov_b32 m0, %5\n\ts_nop 0\n\tglobal_load_lds_dwordx4 %2, off\n\t"
                 "s_mov_b32 m0, %6\n\ts_nop 0\n\tglobal_load_lds_dwordx4 %3, off\n\ts_mov_b32 m0, %0" : "=&s"(keep) : "v"(g0), "v"(g1), "v"(g2), "s"(d0), "s"(d1), "s"(d2) : "memory"); }
#define FA_WAIT_BAR(N) asm volatile("s_waitcnt vmcnt(" #N ") lgkmcnt(0)\n\ts_barrier" ::: "memory")
constexpr int NSLOT = 4, SHM_V = 8192, SHM_KMAX = 16384, OFF_K = 0, OFF_V = NSLOT * SHM_KMAX, OFF_WS = OFF_V + 8 * SHM_V;
struct Src {
    const bf16_t* Q; int ldq;
    bf16_t* O;
    const bf16_t* K; int ldk;
    const bf16_t* KR;
    const bf16_t* V; int ldv;
    int NT;
    int ctx_row0;
    int x_row0;
    int kloc0;
    int q0;
    float sink_l2;
};
template <int DQ, bool WIN>
DEV void attn_unit(const Src& s, unsigned char* lds) {
    constexpr int ND = DQ / 16, KROWB = (DQ == 96) ? 256 : 128, SHM_K = 64 * KROWB, NKP = (DQ == 96) ? 2 : 1;
    constexpr int NSL = WIN ? 8 : NSLOT;
    int tid_ = threadIdx.x; asm volatile("" : "+v"(tid_));
    const int tid = tid_, wid = __builtin_amdgcn_readfirstlane(tid >> 6), lane = tid & 63, r32 = lane & 31, hi = lane >> 5;
    unsigned char* V_lds = lds + OFF_V; unsigned char* K_lds = lds + OFF_K;
    const unsigned lds0 = (unsigned)(uintptr_t)lds;
    float* wsf = (float*)(lds + OFF_WS) + wid * 64; float* li_l = wsf; float* al_l = wsf + 32;
    float m_reg = 0.f, l_reg = 0.f; f32x16 o[2]; f32x16 negm; bf16x8 qr[ND];
    { float z_; asm volatile("v_mov_b32 %0, 0" : "=v"(z_));
#pragma unroll
      for (int r = 0; r < 16; ++r) { o[0][r] = z_; o[1][r] = z_; negm[r] = z_; } asm volatile("" : "+v"(negm)); }
    int krow_[NKP]; const char* kbase_[NKP]; unsigned kldb_[NKP];
#pragma unroll
    for (int pc = 0; pc < NKP; ++pc) {
        const int pk = NKP * wid + pc, row = (DQ == 96) ? (4 * pk + (lane >> 4)) : (8 * pk + (lane >> 3)), cs = (DQ == 96) ? (lane & 15) : (lane & 7), lc = cs ^ (row & 7);
        krow_[pc] = row;
        if (DQ == 96 && lc >= 8 && lc < 12) { kbase_[pc] = (const char*)s.KR + (lc - 8) * 16; kldb_[pc] = 64u; }
        else { kbase_[pc] = (const char*)s.K + ((lc < 8) ? lc : 0) * 16; kldb_[pc] = (unsigned)s.ldk * 2u; }
    }
    int vkey_; const char* vbase_;
    { const int st = 2 * wid + (lane >> 5), kk = (st >> 1) * 8 + ((lane & 31) >> 2), col = (st & 1) * 32 + (lane & 3) * 8;
        vkey_ = kk; vbase_ = (const char*)s.V + col * 2; }
    const unsigned vldb_ = (unsigned)s.ldv * 2u;
#define FA_KEYROW(t, i) (((t) < 4) ? (s.ctx_row0 + (t) * 64 + (i)) : (s.x_row0 + (WIN ? min(max(s.kloc0 + ((t) - 4) * 64 + (i), 0), SEQ - 1) : (((t) - 4) * 64 + (i)))))
#define FA_DMA(t) do { const int sl_ = (t) & (NSL - 1); \
        _Pragma("unroll") for (int pc = 0; pc < NKP; ++pc) { const unsigned kr_ = (unsigned)FA_KEYROW((t), krow_[pc]); \
            glds16(kbase_[pc] + (size_t)kr_ * kldb_[pc], (unsigned)__builtin_amdgcn_readfirstlane(lds0 + OFF_K + sl_ * SHM_K + (NKP * wid + pc) * 1024)); } \
        { const unsigned vr_ = (unsigned)FA_KEYROW((t), vkey_); glds16(vbase_ + (size_t)vr_ * vldb_, (unsigned)__builtin_amdgcn_readfirstlane(lds0 + OFF_V + sl_ * SHM_V + wid * 1024)); } } while (0)
    const char* pk0_ = nullptr; const char* pk1_ = nullptr; const char* pv_ = nullptr; unsigned kdst0_ = 0, vdst0_ = 0;
    if (!WIN) { pk0_ = kbase_[0] + (size_t)(unsigned)(s.ctx_row0 + 192 + krow_[0]) * kldb_[0]; pk1_ = kbase_[NKP - 1] + (size_t)(unsigned)(s.ctx_row0 + 192 + krow_[NKP - 1]) * kldb_[NKP - 1];
        pv_ = vbase_ + (size_t)(unsigned)(s.ctx_row0 + 192 + vkey_) * vldb_;
        kdst0_ = (unsigned)__builtin_amdgcn_readfirstlane(lds0 + OFF_K + (NKP * wid) * 1024); vdst0_ = (unsigned)__builtin_amdgcn_readfirstlane(lds0 + OFF_V + wid * 1024); }
#define FA_DMAF(t) do { const unsigned kd_ = kdst0_ + (unsigned)((t) & (NSL - 1)) * SHM_K, vd_ = vdst0_ + (unsigned)((t) & (NSL - 1)) * SHM_V; \
        glds16x3(pk0_, kd_, pk1_, kd_ + 1024u, pv_, vd_); \
        pk0_ += (size_t)(64u * kldb_[0]); pk1_ += (size_t)(64u * kldb_[NKP - 1]); pv_ += (size_t)(64u * vldb_); \
        if ((t) == 3) { asm volatile("" ::: "memory");              \
            const long jr_ = (long)s.x_row0 - (long)(s.ctx_row0 + 256); pk0_ += jr_ * (long)kldb_[0]; pk1_ += jr_ * (long)kldb_[NKP - 1]; pv_ += jr_ * (long)vldb_; } } while (0)
#define FA_WAITN(tiles_left) do { if ((tiles_left) >= 2) { if (NKP == 2) FA_WAIT_BAR(6); else FA_WAIT_BAR(4); } else if ((tiles_left) == 1) { if (NKP == 2) FA_WAIT_BAR(3); else FA_WAIT_BAR(2); } else FA_WAIT_BAR(0); } while (0)
#define FA_RESC(a) do { if (__any((a) < 1.f)) { if (hi == 0) al_l[r32] = (a); asm volatile("s_waitcnt lgkmcnt(0)" ::: "memory"); \
        _Pragma("unroll") for (int r = 0; r < 16; ++r) { const float f_ = al_l[crow(r, hi)]; o[0][r] *= f_; o[1][r] *= f_; } } } while (0)
#define FA_KRD(d0_, A_, B_) do { const int cb = (((d0_) & 3) * 16 + hi * 8) * 2;     \
            A_ = *reinterpret_cast<const bf16x8*>(Ks + r32 * KROWB + (cb ^ ((r32 & 7) << 4)) + ((d0_) >> 2) * 128); \
            B_ = *reinterpret_cast<const bf16x8*>(Ks + (32 + r32) * KROWB + (cb ^ ((r32 & 7) << 4)) + ((d0_) >> 2) * 128); } while (0)
#define FA_QKT(p0, p1, t) do { const unsigned char* Ks = K_lds + ((t) & (NSL - 1)) * SHM_K; p0 = negm; p1 = negm; bf16x8 ka_, kb_, kc_, kd_; \
        FA_KRD(0, ka_, kb_); \
        _Pragma("unroll") for (int d0 = 0; d0 < ND; d0 += 2) { \
            FA_KRD(d0 + 1, kc_, kd_); asm volatile("" ::: "memory"); \
            p0 = __builtin_amdgcn_mfma_f32_32x32x16_bf16(ka_, qr[d0], p0, 0, 0, 0); \
            p1 = __builtin_amdgcn_mfma_f32_32x32x16_bf16(kb_, qr[d0], p1, 0, 0, 0); \
            if (d0 + 2 < ND) { FA_KRD(d0 + 2, ka_, kb_); asm volatile("" ::: "memory"); } \
            p0 = __builtin_amdgcn_mfma_f32_32x32x16_bf16(kc_, qr[d0 + 1], p0, 0, 0, 0); \
            p1 = __builtin_amdgcn_mfma_f32_32x32x16_bf16(kd_, qr[d0 + 1], p1, 0, 0, 0); } \
        if (WIN) { const int kb = s.kloc0 + ((t) - 4) * 64, dk_ = kb - (s.q0 + wid * 32);     \
            if ((t) >= 4 && !(dk_ >= -97 && dk_ <= 65 && kb >= 0 && kb + 63 < SEQ)) { const int qp = s.q0 + wid * 32 + r32; \
            const int lo_ = max(qp - 128, 0), hi_ = min(qp + 128, SEQ - 1); const unsigned span_ = (unsigned)(hi_ - lo_); const int kbl_ = kb + 4 * hi - lo_;     \
            _Pragma("unroll") for (int r = 0; r < 16; ++r) { const int c_ = (r & 3) + 8 * (r >> 2); \
                if ((unsigned)(kbl_ + c_) > span_) p0[r] = -INFINITY; \
                if ((unsigned)(kbl_ + c_ + 32) > span_) p1[r] = -INFINITY; } } } } while (0)
#define FA_PV(t) do { const int vb_ = (int)(uintptr_t)V_lds + ((t) & (NSL - 1)) * SHM_V + v_rd_base(lane); pv_one<0>(o[0], vb_, pa0, pa1, pa2, pa3); pv_one<1>(o[1], vb_, pa0, pa1, pa2, pa3); } while (0)
#define FA_VU(u, Y0, Y1) do { if ((u) < 8) { Y1[2 * ((u) & 7)] = __builtin_amdgcn_exp2f(Y1[2 * ((u) & 7)]); Y1[2 * ((u) & 7) + 1] = __builtin_amdgcn_exp2f(Y1[2 * ((u) & 7) + 1]); \
            if ((u) == 0) ps_ = Y0[0] + Y0[1]; else { ps_ += Y0[2 * ((u) & 7)]; ps_ += Y0[2 * ((u) & 7) + 1]; } wq_[((u) >> 2) & 3][(u) & 3] = cvtpk(Y0[2 * ((u) & 7)], Y0[2 * ((u) & 7) + 1]); } \
        else { ps_ += Y1[2 * ((u) & 7)]; ps_ += Y1[2 * ((u) & 7) + 1]; wq_[((u) >> 2) & 3][(u) & 3] = cvtpk(Y1[2 * ((u) & 7)], Y1[2 * ((u) & 7) + 1]); } } while (0)
#define FA_GAP(g, Y0, Y1) do { if (ND == 6) { if ((g) < 8) FA_VU((g), Y0, Y1); else { FA_VU(2 * (g) - 8, Y0, Y1); FA_VU(2 * (g) - 7, Y0, Y1); } } \
        else { FA_VU((g), Y0, Y1); FA_VU(8 + (g), Y0, Y1); } asm volatile("" : "+v"(ps_)); FA_SBAR(); } while (0)
#define FA_SEG1(X0, X1, Y0, Y1, alY, t, DOD) do { const unsigned char* Ks = K_lds + ((t) & (NSL - 1)) * SHM_K; bf16x8 ka_, kb_, kc_, kd_; float ps_ = 0.f; u32x4 wq_[4]; \
        FA_KRD(0, ka_, kb_); FA_KRD(1, kc_, kd_); FA_SBAR(); \
        if (WIN) { if ((DOD) && (t) + 2 < NT) FA_DMA((t) + 2); } else if (DOD) FA_DMAF((t) + 2); \
        FA_RESC(alY); FA_SBAR(); \
          \
        _Pragma("unroll") for (int d0 = 0; d0 < ND; d0 += 2) { \
            if (d0 == 0) { X1 = __builtin_amdgcn_mfma_f32_32x32x16_bf16(kb_, qr[0], negm, 0, 0, 0); FA_GAP(0, Y0, Y1); X0 = __builtin_amdgcn_mfma_f32_32x32x16_bf16(ka_, qr[0], negm, 0, 0, 0); FA_GAP(1, Y0, Y1); } \
            else { X1 = __builtin_amdgcn_mfma_f32_32x32x16_bf16(kb_, qr[d0], X1, 0, 0, 0); FA_GAP(2 * d0, Y0, Y1); X0 = __builtin_amdgcn_mfma_f32_32x32x16_bf16(ka_, qr[d0], X0, 0, 0, 0); FA_GAP(2 * d0 + 1, Y0, Y1); } \
            if (d0 + 2 < ND) { FA_KRD(d0 + 2, ka_, kb_); } \
            X1 = __builtin_amdgcn_mfma_f32_32x32x16_bf16(kd_, qr[d0 + 1], X1, 0, 0, 0); FA_GAP(2 * d0 + 2, Y0, Y1); X0 = __builtin_amdgcn_mfma_f32_32x32x16_bf16(kc_, qr[d0 + 1], X0, 0, 0, 0); FA_GAP(2 * d0 + 3, Y0, Y1); \
            if (d0 + 3 < ND) { FA_KRD(d0 + 3, kc_, kd_); } } \
        l_reg = l_reg * (alY) + ps_; \
        pa0 = *reinterpret_cast<bf16x8*>(&wq_[0]); pa1 = *reinterpret_cast<bf16x8*>(&wq_[1]); pa2 = *reinterpret_cast<bf16x8*>(&wq_[2]); pa3 = *reinterpret_cast<bf16x8*>(&wq_[3]); \
        if (WIN) { const int kb = s.kloc0 + ((t) - 4) * 64, dk_ = kb - (s.q0 + wid * 32); \
            if ((t) >= 4 && !(dk_ >= -97 && dk_ <= 65 && kb >= 0 && kb + 63 < SEQ)) { const int qp = s.q0 + wid * 32 + r32; \
            const int lo_ = max(qp - 128, 0), hi_ = min(qp + 128, SEQ - 1); const unsigned span_ = (unsigned)(hi_ - lo_); const int kbl_ = kb + 4 * hi - lo_; \
            _Pragma("unroll") for (int r = 0; r < 16; ++r) { const int c_ = (r & 3) + 8 * (r >> 2); \
                if ((unsigned)(kbl_ + c_) > span_) X0[r] = -INFINITY; \
                if ((unsigned)(kbl_ + c_ + 32) > span_) X1[r] = -INFINITY; } } } } while (0)
#define FA_PKV(L, H) (bf16x8){L[0], L[1], L[2], L[3], H[0], H[1], H[2], H[3]}
#define FA_EXP4(X, b) do { X[(b)] = __builtin_amdgcn_exp2f(X[(b)]); X[(b) + 1] = __builtin_amdgcn_exp2f(X[(b) + 1]); X[(b) + 2] = __builtin_amdgcn_exp2f(X[(b) + 2]); X[(b) + 3] = __builtin_amdgcn_exp2f(X[(b) + 3]); } while (0)
#define FA_SEG2(X0, X1, alX, tp) do { const int vb_ = (int)(uintptr_t)V_lds + ((tp) & (NSL - 1)) * SHM_V + v_rd_base(lane); \
        const s16x4 l0 = tr_read<v_rd_off(0, 0, 0)>(vb_), h0 = tr_read<v_rd_off(0, 0, 1)>(vb_), l1 = tr_read<v_rd_off(0, 1, 0)>(vb_), h1 = tr_read<v_rd_off(0, 1, 1)>(vb_); \
        const s16x4 l2 = tr_read<v_rd_off(0, 2, 0)>(vb_), h2 = tr_read<v_rd_off(0, 2, 1)>(vb_), l3 = tr_read<v_rd_off(0, 3, 0)>(vb_), h3 = tr_read<v_rd_off(0, 3, 1)>(vb_); \
          \
          \
        float a_ = max3f(X1[0], X1[1], X1[2]), c_ = max3f(X1[7], X1[8], X1[9]), b_, d_; a_ = max3f(a_, X1[3], X1[4]); c_ = max3f(c_, X1[10], X1[11]); \
        asm volatile("s_waitcnt lgkmcnt(0)" ::: "memory"); FA_SBAR(); \
        o[0] = __builtin_amdgcn_mfma_f32_32x32x16_bf16(pa0, FA_PKV(l0, h0), o[0], 0, 0, 0); \
        const s16x4 m0_ = tr_read<v_rd_off(1, 0, 0)>(vb_), n0_ = tr_read<v_rd_off(1, 0, 1)>(vb_); a_ = max3f(a_, X1[5], X1[6]); c_ = max3f(c_, X1[12], X1[13]); b_ = max3f(X0[0], X0[1], X0[2]); FA_SBAR(); \
        o[0] = __builtin_amdgcn_mfma_f32_32x32x16_bf16(pa1, FA_PKV(l1, h1), o[0], 0, 0, 0); \
        const s16x4 m1_ = tr_read<v_rd_off(1, 1, 0)>(vb_), n1_ = tr_read<v_rd_off(1, 1, 1)>(vb_); d_ = max3f(X0[7], X0[8], X0[9]); b_ = max3f(b_, X0[3], X0[4]); d_ = max3f(d_, X0[10], X0[11]); FA_SBAR(); \
        o[0] = __builtin_amdgcn_mfma_f32_32x32x16_bf16(pa2, FA_PKV(l2, h2), o[0], 0, 0, 0); \
        const s16x4 m2_ = tr_read<v_rd_off(1, 2, 0)>(vb_), n2_ = tr_read<v_rd_off(1, 2, 1)>(vb_); b_ = max3f(b_, X0[5], X0[6]); d_ = max3f(d_, X0[12], X0[13]); a_ = max3f(a_, c_, X1[14]); FA_SBAR(); \
        o[0] = __builtin_amdgcn_mfma_f32_32x32x16_bf16(pa3, FA_PKV(l3, h3), o[0], 0, 0, 0); \
        const s16x4 m3_ = tr_read<v_rd_off(1, 3, 0)>(vb_), n3_ = tr_read<v_rd_off(1, 3, 1)>(vb_); b_ = max3f(b_, d_, X0[14]); a_ = max3f(a_, X1[15], X0[15]); const float hm_ = max2f(a_, b_); FA_SBAR(); \
        alX = 1.f; \
        if (__builtin_expect(__any(hm_ > THR), 0)) { const float pm_ = mergehalves_max(hm_); const float dl_ = __builtin_fmaxf(pm_, 0.f); m_reg += dl_; \
            _Pragma("unroll") for (int r = 0; r < 16; ++r) { X0[r] -= dl_; X1[r] -= dl_; } \
            _Pragma("unroll") for (int r = 0; r < 16; ++r) negm[r] = -m_reg; \
            asm volatile("" : "+v"(negm)); alX = __builtin_amdgcn_exp2f(-dl_); } \
        asm volatile("s_waitcnt lgkmcnt(0)" ::: "memory"); FA_SBAR(); \
        o[1] = __builtin_amdgcn_mfma_f32_32x32x16_bf16(pa0, FA_PKV(m0_, n0_), o[1], 0, 0, 0); FA_EXP4(X0, 0); asm volatile("" : "+v"(X0)); FA_SBAR(); \
        o[1] = __builtin_amdgcn_mfma_f32_32x32x16_bf16(pa1, FA_PKV(m1_, n1_), o[1], 0, 0, 0); FA_EXP4(X0, 4); asm volatile("" : "+v"(X0)); FA_SBAR(); \
        o[1] = __builtin_amdgcn_mfma_f32_32x32x16_bf16(pa2, FA_PKV(m2_, n2_), o[1], 0, 0, 0); FA_EXP4(X0, 8); asm volatile("" : "+v"(X0)); FA_SBAR(); \
        o[1] = __builtin_amdgcn_mfma_f32_32x32x16_bf16(pa3, FA_PKV(m3_, n3_), o[1], 0, 0, 0); FA_EXP4(X0, 12); asm volatile("" : "+v"(X0)); FA_SBAR(); } while (0)
    const int NT = s.NT;
    FA_DMA(0); FA_DMA(1); FA_DMA(2);
    const bf16_t* Qw = s.Q + (size_t)(wid * 32 + r32) * s.ldq + hi * 8;
#pragma unroll
    for (int d0 = 0; d0 < ND; ++d0) qr[d0] = *reinterpret_cast<const bf16x8*>(Qw + d0 * 16);
    f32x16 pA0, pA1, pB0, pB1; float alA, alB; bf16x8 pa0, pa1, pa2, pa3;
    FA_WAITN(2);
    FA_QKT(pA0, pA1, 0); partialSM<true>(pA0, pA1, m_reg, negm, alA);
    FA_WAITN(1);
    if (!WIN) {
    for (int j = 1; j + 1 < NT; j += 2) {
        FA_SEG1(pB0, pB1, pA0, pA1, alA, j, 1);
        FA_SEG2(pB0, pB1, alB, j - 1);
        FA_WAITN(1);
        FA_SEG1(pA0, pA1, pB0, pB1, alB, j + 1, 1);
        FA_SEG2(pA0, pA1, alA, j);
        FA_WAITN(1);
    }
    FA_SEG1(pB0, pB1, pA0, pA1, alA, NT - 1, 0);
    FA_SEG2(pB0, pB1, alB, NT - 2);
    FA_RESC(alB);
    finishSM(pB0, pB1, alB, l_reg, pa0, pa1, pa2, pa3);
    FA_PV(NT - 1);
    } else if (NT == 12) {
    const int lo_w = wid >> 1;
    FA_DMA(3); FA_DMA(4); FA_DMA(5); FA_DMA(6);
    FA_SEG1(pB0, pB1, pA0, pA1, alA, 1, 0); FA_PV(0); partialSM<false>(pB0, pB1, m_reg, negm, alB);
    FA_WAIT_BAR(8); FA_DMA(7); FA_DMA(8);
    FA_SEG1(pA0, pA1, pB0, pB1, alB, 2, 0); FA_PV(1); partialSM<false>(pA0, pA1, m_reg, negm, alA);
    FA_WAIT_BAR(10); FA_DMA(9);
    FA_SEG1(pB0, pB1, pA0, pA1, alA, 3, 0); FA_PV(2); partialSM<false>(pB0, pB1, m_reg, negm, alB);
    FA_WAIT_BAR(4); FA_DMA(10);
    FA_SEG1(pA0, pA1, pB0, pB1, alB, 4 + lo_w, 0); FA_PV(3); partialSM<false>(pA0, pA1, m_reg, negm, alA);
    FA_WAIT_BAR(4); FA_DMA(11);
    FA_SEG1(pB0, pB1, pA0, pA1, alA, 5 + lo_w, 0); FA_PV(4 + lo_w); partialSM<false>(pB0, pB1, m_reg, negm, alB);
    FA_WAIT_BAR(0);
    FA_SEG1(pA0, pA1, pB0, pB1, alB, 6 + lo_w, 0); FA_PV(5 + lo_w); partialSM<false>(pA0, pA1, m_reg, negm, alA);
    FA_SEG1(pB0, pB1, pA0, pA1, alA, 7 + lo_w, 0); FA_PV(6 + lo_w); partialSM<false>(pB0, pB1, m_reg, negm, alB);
    FA_SEG1(pA0, pA1, pB0, pB1, alB, 8 + lo_w, 0); FA_PV(7 + lo_w); partialSM<false>(pA0, pA1, m_reg, negm, alA);
    FA_RESC(alA);
    finishSM(pA0, pA1, alA, l_reg, pa0, pa1, pa2, pa3);
    FA_PV(8 + lo_w);
    } else { const int NT = 4;
    FA_SEG1(pB0, pB1, pA0, pA1, alA, 1, 1); FA_PV(0); partialSM<false>(pB0, pB1, m_reg, negm, alB);
    FA_WAITN(1);
    FA_SEG1(pA0, pA1, pB0, pB1, alB, 2, 1); FA_PV(1); partialSM<false>(pA0, pA1, m_reg, negm, alA);
    FA_WAITN(0);
    FA_SEG1(pB0, pB1, pA0, pA1, alA, 3, 1); FA_PV(2); partialSM<false>(pB0, pB1, m_reg, negm, alB);
    FA_RESC(alB);
    finishSM(pB0, pB1, alB, l_reg, pa0, pa1, pa2, pa3);
    FA_PV(3);
    }
    { auto rr = __builtin_amdgcn_permlane32_swap(__float_as_uint(l_reg), __float_as_uint(l_reg), false, false); l_reg = __uint_as_float(rr[0]) + __uint_as_float(rr[1]); }
    if (WIN) l_reg += __builtin_amdgcn_exp2f(s.sink_l2 - m_reg);
    int hi_e = hi, r32_e = r32; asm volatile("" : "+v"(hi_e), "+v"(r32_e));
    if (hi_e == 0) li_l[r32_e] = l_reg; asm volatile("s_waitcnt lgkmcnt(0)" ::: "memory");
    bf16_t* Ow = s.O + (size_t)(wid * 32) * s.ldq;
#pragma unroll
    for (int r = 0; r < 16; ++r) { const int orow = crow(r, hi_e); const float rl = __builtin_amdgcn_rcpf(li_l[orow]);
#pragma unroll
        for (int d0 = 0; d0 < 2; ++d0) Ow[(size_t)orow * s.ldq + d0 * 32 + r32_e] = (bf16_t)f2bf(o[d0][r] * rl); }
    FA_WAIT_BAR(0);
#undef FA_KEYROW
#undef FA_DMA
#undef FA_DMAF
#undef FA_WAITN
#undef FA_RESC
#undef FA_QKT
#undef FA_KRD
#undef FA_PV
#undef FA_VU
#undef FA_GAP
#undef FA_SEG1
#undef FA_SEG2
#undef FA_PKV
#undef FA_EXP4
}
}
DEV void phase_attn_fast(const Ctx& c, int l) {
    const bool last = (l == DEPTH - 1);
    const int nx = NB * 8 * 16, nc = last ? 0 : NB * 8;
    const int vcu = (c.G % 8 == 0) ? (int)(blockIdx.x % 8) * (c.G / 8) + (int)(blockIdx.x / 8) : (int)blockIdx.x;
    for (int it = vcu; it < nx + nc; it += c.G) {
        int r = it; const bool ctxq = r >= nx; if (ctxq) r -= nx;
        int b, h, qb;
        if (!ctxq) { qb = r & 15; h = (r >> 4) & 7; b = r >> 7; } else { qb = 0; h = r & 7; b = r >> 3; }
        const int qrow0 = ctxq ? (RX + b * LC) : (b * SEQ + qb * 256);
        fa::Src s; s.ctx_row0 = RX + b * LC; s.x_row0 = b * SEQ; s.q0 = qb * 256;
        s.Q = (const bf16_t*)(c.ws + WS_QB) + (size_t)qrow0 * 768 + h * 96; s.ldq = 768; s.O = (bf16_t*)(c.ws + WS_QB) + (size_t)qrow0 * 768 + h * 96;
        s.K = (const bf16_t*)(c.ws + WS_KNB) + h * 64; s.ldk = 512; s.KR = (const bf16_t*)(c.dout + DO_KR); s.V = (const bf16_t*)(c.ws + WS_VB) + h * 64; s.ldv = 512;
        s.NT = ctxq ? 4 : 68; s.kloc0 = 0; s.sink_l2 = 0.f;
        fa::attn_unit<96, false>(s, c.lds);
    }
    asm volatile("" ::: "memory");
    for (int it = (vcu + c.G - nc) % c.G; it < nx + nc; it += c.G) {
        int r = it; bool ctxq = r >= nx; if (ctxq) r = (r - nx + nc / 2) % (nc > 0 ? nc : 1);
        int b, h, qb;
        if (!ctxq) { qb = r & 15; h = (r >> 4) & 7; b = r >> 7; } else { qb = 0; h = r & 7; b = r >> 3; }
        const int qrow0 = ctxq ? (RX + b * LC) : (b * SEQ + qb * 256);
        fa::Src s; s.ctx_row0 = RX + b * LC; s.x_row0 = b * SEQ; s.q0 = qb * 256;
        const int kvh = h >> 2;
        s.Q = (const bf16_t*)(c.ws + WS_QA) + (size_t)qrow0 * 512 + h * 64; s.ldq = 512; s.O = (bf16_t*)(c.ws + WS_QA) + (size_t)qrow0 * 512 + h * 64;
        s.K = (const bf16_t*)(c.dout + DO_KA) + kvh * 64; s.ldk = 128; s.KR = nullptr; s.V = (const bf16_t*)(c.dout + DO_VA) + kvh * 64; s.ldv = 128;
        s.NT = ctxq ? 4 : 12; s.kloc0 = qb * 256 - 128; s.sink_l2 = c.p->in[I_SINK + c.z][l * 8 + h] * LOG2E;
        fa::attn_unit<64, true>(s, c.lds);
    }
    phase_pool(c, last ? RX : R);
}

typedef float f32x16 __attribute__((ext_vector_type(16)));
DEV void phase_router(const Ctx& c, int l) {
    const Params& p = *c.p; const int nrows = (l == DEPTH - 1) ? RX : R, ntask = nrows / 16;
    int* cnt = (int*)(c.ws + WS_CNT) + l * 32; int* list = (int*)(c.ws + WS_LIST); float* gate = (float*)(c.ws + WS_GATE);
    float* wrg_l = (float*)c.lds; float* gs_l = (float*)(c.lds + 16384) + c.wave * 2048; float* sh_l = gs_l + 1024; float* sc_l = (float*)(c.lds + 16384 + 65536) + c.wave * (16 * 33);
    for (int i = c.tid; i < 1024; i += 512) *(f32x4*)(wrg_l + 4 * i) = *(const f32x4*)(p.in[I_WRG + c.z] + (size_t)l * 4096 + 4 * i);
    __syncthreads();
    const int i_ = c.lane & 15, kq = c.lane >> 4;
    int* sel_l = (int*)(c.lds + 16384 + 65536 + 8 * 16 * 33 * 4); int* lrk_l = sel_l + 256; int* base_l = lrk_l + 256;
    const bool split = (nrows == R) && (c.G == 256);
    const int nt_full = split ? RX / 16 : ntask;
    float* glp_l = (float*)(c.lds + 16384 + 65536 + 8 * 16 * 33 * 4 + 2560);
    bool coop_done = false;
    for (int t = c.gw; ; t += c.NGW) {
        bool coop = false;
        if (t >= nt_full) { if (!split || coop_done) break; coop = true; coop_done = true; }
        int e1 = 0, e2 = 0; float g1v = 0.f, g2v = 0.f;
        const int row0 = coop ? (RX + 8 * (int)blockIdx.x) : t * 16, mb = mod_idx(row0), row = coop ? (row0 + (i_ & 7)) : (row0 + i_);
        const int it_lo = coop ? 2 * c.wave : 0, it_hi = coop ? 2 * c.wave + 2 : 16;
        { const float* g = p.in[I_GFFN + c.z] + l * DM; const float* sh = modp(c.ws, l, mb, 3); const float* scl = modp(c.ws, l, mb, 4);
#pragma unroll
            for (int j = 0; j < 4; ++j) { const int col = 4 * c.lane + 256 * j; const f32x4 gg = *(const f32x4*)(g + col), s1 = *(const f32x4*)(sh + col), s2 = *(const f32x4*)(scl + col);
                f32x4 a; a.x = gg.x * (1.f + s2.x); a.y = gg.y * (1.f + s2.y); a.z = gg.z * (1.f + s2.z); a.w = gg.w * (1.f + s2.w);
                *(f32x4*)(gs_l + col) = a; *(f32x4*)(sh_l + col) = s1; } }
        float rstd;
        { const float* sq = (const float*)(c.dout + DO_SSQH) + (size_t)row * 16; const f32x4 a = *(const f32x4*)sq, b = *(const f32x4*)(sq + 4), d = *(const f32x4*)(sq + 8), e = *(const f32x4*)(sq + 12);
            const float s = (((a.x + a.y) + (a.z + a.w)) + ((b.x + b.y) + (b.z + b.w))) + (((d.x + d.y) + (d.z + d.w)) + ((e.x + e.y) + (e.z + e.w)));
            rstd = rsqrtf(s * (1.f / DM) + EPS); }
        const bf16_t* hrow = (const bf16_t*)(c.ws + WS_H) + (size_t)row * DM + 8 * kq;
        bf16_t* fxrow = (bf16_t*)(c.ws + WS_FX) + (size_t)row * DM + 8 * kq;
        const float* Bp = (const float*)(c.ws + c.wre) + c.lane * 8;
        f32x4 acc0 = {0.f, 0.f, 0.f, 0.f}, acc1 = {0.f, 0.f, 0.f, 0.f}; float gl0 = 0.f, gl1 = 0.f, gl2 = 0.f, gl3 = 0.f;
        u32x4 hc[2], hn[2]; f32x4 bc[2][4], bn[2][4];
#pragma unroll
        for (int q = 0; q < 2; ++q) { hc[q] = *(const u32x4*)(hrow + 32 * (it_lo * 2 + q));
#pragma unroll
            for (int v = 0; v < 4; ++v) bc[q][v] = *(const f32x4*)(Bp + (it_lo * 2 + q) * 1024 + (v >> 1) * 512 + (v & 1) * 4); }
#pragma unroll 1
        for (int it = it_lo; it < it_hi; ++it) {
            const int nb = (it + 1 < it_hi ? it + 1 : it_hi - 1) * 2;
#pragma unroll
            for (int q = 0; q < 2; ++q) { hn[q] = *(const u32x4*)(hrow + 32 * (nb + q));
#pragma unroll
                for (int v = 0; v < 4; ++v) bn[q][v] = *(const f32x4*)(Bp + (nb + q) * 1024 + (v >> 1) * 512 + (v & 1) * 4); }
#pragma unroll
            for (int q = 0; q < 2; ++q) { const int cc2 = it * 2 + q;
                float h8[8]; unpack8(hc[q], h8);
                const f32x4 ga = *(const f32x4*)(gs_l + 32 * cc2 + 8 * kq), gb = *(const f32x4*)(gs_l + 32 * cc2 + 8 * kq + 4), sa = *(const f32x4*)(sh_l + 32 * cc2 + 8 * kq), sb = *(const f32x4*)(sh_l + 32 * cc2 + 8 * kq + 4);
                float fx[8];
#pragma unroll
                for (int u = 0; u < 4; ++u) { fx[u] = h8[u] * rstd * ga[u] + sa[u]; fx[4 + u] = h8[4 + u] * rstd * gb[u] + sb[u]; }
                u32x4 w; w.x = pk2(fx[0], fx[1]); w.y = pk2(fx[2], fx[3]); w.z = pk2(fx[4], fx[5]); w.w = pk2(fx[6], fx[7]); *(u32x4*)(fxrow + 32 * cc2) = w;
#pragma unroll
                for (int u = 0; u < 8; ++u) { acc0 = __builtin_amdgcn_mfma_f32_16x16x4f32(fx[u], bc[q][u >> 2][u & 3], acc0, 0, 0, 0); acc1 = __builtin_amdgcn_mfma_f32_16x16x4f32(fx[u], bc[q][2 + (u >> 2)][u & 3], acc1, 0, 0, 0); }
#pragma unroll
                for (int u = 0; u < 8; ++u) { const f32x4 wg = *(const f32x4*)(wrg_l + (32 * cc2 + 8 * kq + u) * 4); gl0 += fx[u] * wg.x; gl1 += fx[u] * wg.y; gl2 += fx[u] * wg.z; gl3 += fx[u] * wg.w; } }
#pragma unroll
            for (int q = 0; q < 2; ++q) { hc[q] = hn[q];
#pragma unroll
                for (int v = 0; v < 4; ++v) bc[q][v] = bn[q][v]; }
        }
        gl0 += __shfl_xor(gl0, 16); gl1 += __shfl_xor(gl1, 16); gl2 += __shfl_xor(gl2, 16); gl3 += __shfl_xor(gl3, 16);
        gl0 += __shfl_xor(gl0, 32); gl1 += __shfl_xor(gl1, 32); gl2 += __shfl_xor(gl2, 32); gl3 += __shfl_xor(gl3, 32);
        { const float be0 = coop ? 0.f : p.in[I_BRE + c.z][l * 32 + i_], be1 = coop ? 0.f : p.in[I_BRE + c.z][l * 32 + 16 + i_];
#pragma unroll
            for (int r = 0; r < 4; ++r) { sc_l[(4 * kq + r) * 33 + i_] = acc0[r] + be0; sc_l[(4 * kq + r) * 33 + 16 + i_] = acc1[r] + be1; } }
        if (coop) {
            if (kq == 0) { float* gp_ = glp_l + (c.wave * 16 + i_) * 4; gp_[0] = gl0; gp_[1] = gl1; gp_[2] = gl2; gp_[3] = gl3; }
            if (c.tid < 256) sel_l[c.tid] = -1;
            __syncthreads();
            if (c.wave == 0) {
                const float* sc0 = (const float*)(c.lds + 16384 + 65536);
                float a0[4], a1[4];
#pragma unroll
                for (int r = 0; r < 4; ++r) { float x0 = p.in[I_BRE + c.z][l * 32 + i_], x1 = p.in[I_BRE + c.z][l * 32 + 16 + i_];
#pragma unroll
                    for (int w = 0; w < 8; ++w) { x0 += sc0[w * (16 * 33) + (4 * kq + r) * 33 + i_]; x1 += sc0[w * (16 * 33) + (4 * kq + r) * 33 + 16 + i_]; }
                    a0[r] = x0; a1[r] = x1; }
                float t0 = 0.f, t1 = 0.f, t2 = 0.f, t3 = 0.f;
#pragma unroll
                for (int w = 0; w < 8; ++w) { const float* gp_ = glp_l + (w * 16 + i_) * 4; t0 += gp_[0]; t1 += gp_[1]; t2 += gp_[2]; t3 += gp_[3]; }
                gl0 = t0; gl1 = t1; gl2 = t2; gl3 = t3;
                __builtin_amdgcn_s_waitcnt(0xc07f); __builtin_amdgcn_wave_barrier();
#pragma unroll
                for (int r = 0; r < 4; ++r) { sc_l[(4 * kq + r) * 33 + i_] = a0[r]; sc_l[(4 * kq + r) * 33 + 16 + i_] = a1[r]; }
            }
        }
        __builtin_amdgcn_s_waitcnt(0xc07f); __builtin_amdgcn_wave_barrier();
        const bool act = coop ? (c.wave == 0 && kq == 0 && i_ < 8) : (kq == 0);
        if (act) {
            float lg[4]; lg[0] = gl0 + p.in[I_BRG + c.z][l * 4 + 0]; lg[1] = gl1 + p.in[I_BRG + c.z][l * 4 + 1]; lg[2] = gl2 + p.in[I_BRG + c.z][l * 4 + 2]; lg[3] = gl3 + p.in[I_BRG + c.z][l * 4 + 3];
            int gsel = 0; float gm = lg[0];
#pragma unroll
            for (int j = 1; j < 4; ++j) if (lg[j] > gm) { gm = lg[j]; gsel = j; }
            float den = 0.f;
#pragma unroll
            for (int j = 0; j < 4; ++j) den += __expf(lg[j] - gm);
            const float gp = 1.f / den;
            float e[8];
#pragma unroll
            for (int i = 0; i < 8; ++i) e[i] = sc_l[i_ * 33 + gsel * 8 + i];
            int i1 = 0; float v1 = e[0];
#pragma unroll
            for (int i = 1; i < 8; ++i) if (e[i] > v1) { v1 = e[i]; i1 = i; }
            int i2 = -1; float v2 = -3.0e38f;
#pragma unroll
            for (int i = 0; i < 8; ++i) if (i != i1 && e[i] > v2) { v2 = e[i]; i2 = i; }
            const float ex = __expf(v2 - v1); const float p1 = 1.f / (1.f + ex), p2 = ex / (1.f + ex);
            e1 = gsel * 8 + i1; e2 = gsel * 8 + i2; g1v = p1 * gp; g2v = p2 * gp;
            sel_l[c.wave * 32 + 2 * i_] = e1; sel_l[c.wave * 32 + 2 * i_ + 1] = e2;
        }
        __syncthreads();
        if (c.tid < 32) { int n = 0;
#pragma unroll 1
            for (int q0 = 0; q0 < 256; q0 += 16) { int ev[16];
#pragma unroll
                for (int q = 0; q < 16; ++q) ev[q] = sel_l[q0 + q];
#pragma unroll
                for (int q = 0; q < 16; ++q) if (ev[q] == c.tid) { lrk_l[q0 + q] = n; ++n; } }
            int base = 0; if (n > 0) base = atomicAdd(cnt + c.tid, n);
            base_l[c.tid] = base; }
        __syncthreads();
        if (act) {
            const int r1 = base_l[e1] + lrk_l[c.wave * 32 + 2 * i_], r2 = base_l[e2] + lrk_l[c.wave * 32 + 2 * i_ + 1];
            list[(size_t)e1 * R + r1] = row * 2; list[(size_t)e2 * R + r2] = row * 2 + 1;
            { float* lg_ = (float*)(c.dout + DO_LGATE); lg_[(size_t)e1 * R + r1] = g1v; lg_[(size_t)e2 * R + r2] = g2v; }
            gate[row * 2] = g1v; gate[row * 2 + 1] = g2v;
        }
        __syncthreads();
    }
    __syncthreads();
}

#define BFP(off) ((const bf16_t*)(c->ws + (off)))
struct SInproj { const Ctx* c; pg8::TileOrder o;
    DEV bool next(int i, pg8::Unit& u) const { int pm, pn; if (!o.get(i, pm, pn)) return false;
        u.A = BFP(WS_XN) + (size_t)pm * 256 * 1024; u.Bt = BFP(c->wofs + W_IN) + (size_t)pn * 256 * 1024; u.lda = 1024; u.kstepA = 128; u.row0 = pm * 256; u.col0 = pn * 256; u.aux = 0; u.keep = 0; u.gl = nullptr; u.gn = 0; return true; } };
struct EInproj { const Ctx* c;
    DEV void operator()(f32x4 (&acc)[2][2][4][2], const pg8::Unit& u, int wr, int wc, int fr, int fq) const {
        const int which = (u.col0 == C_CQ) ? 0 : (u.col0 == C_CKV) ? 1 : -1;
        const bool rope = (u.row0 < RX) && (u.col0 < C_VA || u.col0 == C_KR);
#pragma unroll
        for (int ai = 0; ai < 2; ++ai)
#pragma unroll
        for (int mh = 0; mh < 2; ++mh) {
            f32x4 tb[2][2][2];
#pragma unroll
            for (int m2 = 0; m2 < 2; ++m2)
#pragma unroll
                for (int bj = 0; bj < 2; ++bj) { tb[m2][bj][0] = (f32x4){1.f, 0.f, 1.f, 0.f}; tb[m2][bj][1] = (f32x4){1.f, 0.f, 1.f, 0.f};
                    const int col0 = u.col0 + bj * 128 + wc * 32 + 8 * fq;
                    if (rope && (u.col0 != C_KA || bj == 0) && (u.col0 != C_KR || col0 < C_END)) { const f32x4* t = inproj_tab(*c, u.row0 + ai * 128 + wr * 64 + (mh * 2 + m2) * 16 + fr, col0); tb[m2][bj][0] = t[0]; tb[m2][bj][1] = t[1]; } }
#pragma unroll
            for (int m2 = 0; m2 < 2; ++m2) { const int m = mh * 2 + m2; const int row = u.row0 + ai * 128 + wr * 64 + m * 16 + fr; float ss = 0.f;
#pragma unroll
                for (int bj = 0; bj < 2; ++bj) { const int col0 = u.col0 + bj * 128 + wc * 32 + 8 * fq;
                    float v[8]; const f32x4 x0 = acc[ai][bj][m][0], x1 = acc[ai][bj][m][1];
                    v[0] = x0[0]; v[1] = x0[1]; v[2] = x0[2]; v[3] = x0[3]; v[4] = x1[0]; v[5] = x1[1]; v[6] = x1[2]; v[7] = x1[3];
                    epi_inproj(*c, row, col0, v, tb[m2][bj]);
#pragma unroll
                    for (int i = 0; i < 8; ++i) ss += v[i] * v[i]; }
                if (which >= 0) { ss += __shfl_xor(ss, 16); ss += __shfl_xor(ss, 32);
                    if (fq == 0) ((float*)(c->ws + WS_SSQ))[(size_t)(row * 2 + which) * 4 + wc] = ss; } }
            asm volatile("" ::: "memory"); } } };
struct SUp { const Ctx* c; pg8::TileOrder o;
    DEV bool next(int i, pg8::Unit& u) const { int pm, pn; if (!o.get(i, pm, pn)) return false;
        if (pn < 3) { u.A = BFP(WS_CQ) + (size_t)pm * 256 * 256; u.Bt = BFP(c->wofs + W_UQ) + (size_t)pn * 256 * 256; u.col0 = pn * 256; u.aux = 0; }
        else { u.A = BFP(WS_CKV) + (size_t)pm * 256 * 256; u.Bt = BFP(c->wofs + W_UKV) + (size_t)(pn - 3) * 256 * 256; u.col0 = (pn - 3) * 256; u.aux = 1; }
        u.lda = 256; u.kstepA = 128; u.row0 = pm * 256; u.keep = 0; u.gl = nullptr; u.gn = 0; return true; } };
struct EUp { const Ctx* c;
    DEV void operator()(f32x4 (&acc)[2][2][4][2], const pg8::Unit& u, int wr, int wc, int fr, int fq) const {
        float rs[2][4];
#pragma unroll
        for (int ai = 0; ai < 2; ++ai)
#pragma unroll
            for (int m = 0; m < 4; ++m) { const int row = u.row0 + ai * 128 + wr * 64 + m * 16 + fr;
                const f32x4 sq = *(const f32x4*)((const float*)(c->ws + WS_SSQ) + (size_t)(row * 2 + u.aux) * 4); rs[ai][m] = rsqrtf(((sq.x + sq.y) + (sq.z + sq.w)) * (1.f / 256.f) + EPS); }
#pragma unroll
        for (int ai = 0; ai < 2; ++ai) {
#pragma unroll
            for (int m = 0; m < 4; ++m) { const int row = u.row0 + ai * 128 + wr * 64 + m * 16 + fr;
#pragma unroll
                for (int bj = 0; bj < 2; ++bj) { const int col0 = u.col0 + bj * 128 + wc * 32 + 8 * fq;
                    float v[8]; const f32x4 x0 = acc[ai][bj][m][0], x1 = acc[ai][bj][m][1];
                    v[0] = x0[0]; v[1] = x0[1]; v[2] = x0[2]; v[3] = x0[3]; v[4] = x1[0]; v[5] = x1[1]; v[6] = x1[2]; v[7] = x1[3];
                    if (u.aux == 0) epi_upq(*c, row, col0, v, rs[ai][m] * SCALE_B); else epi_upkv(*c, row, col0, v, rs[ai][m]); } }
            asm volatile("" ::: "memory"); } } };
struct SBranch { const Ctx* c; pg8::TileOrder o;
    DEV bool next(int i, pg8::Unit& u) const { int pm, pn; const int pair = i / 3, br = i - pair * 3; if (!o.get(pair, pm, pn)) return false;
        if (br == 0) { u.A = BFP(WS_QA) + (size_t)pm * 256 * 512; u.lda = 512; u.kstepA = 128; u.Bt = BFP(c->wofs + W_BA) + (size_t)pn * 256 * 512; }
        else if (br == 1) { u.A = BFP(WS_QB) + (size_t)pm * 256 * 768; u.lda = 768; u.kstepA = 192; u.Bt = BFP(c->wofs + W_BB) + (size_t)pn * 256 * 512; }
        else { u.A = BFP(WS_POOL) + (size_t)pm * 256 * 512; u.lda = 512; u.kstepA = 128; u.Bt = BFP(c->wofs + W_BC) + (size_t)pn * 256 * 512; }
        u.row0 = pm * 256; u.col0 = pn * 256; u.aux = br; u.keep = (br < 2); u.gl = nullptr; u.gn = 0; return true; } };
DEV void gates_u8(const u32x2 w, float (&g)[8]) {
    g[0] = (float)(w.x & 255u); g[1] = (float)((w.x >> 8) & 255u); g[2] = (float)((w.x >> 16) & 255u); g[3] = (float)(w.x >> 24);
    g[4] = (float)(w.y & 255u); g[5] = (float)((w.y >> 8) & 255u); g[6] = (float)((w.y >> 16) & 255u); g[7] = (float)(w.y >> 24); }
struct EBranch { const Ctx* c;
    DEV void operator()(f32x4 (&acc)[2][2][4][2], const pg8::Unit& u, int wr, int wc, int fr, int fq) const {
        const unsigned char* G = c->dout + DO_G;
#pragma unroll
        for (int ai = 0; ai < 2; ++ai) {
            u32x2 ga[4][2], gb[4][2];
#pragma unroll
            for (int m = 0; m < 4; ++m)
#pragma unroll
                for (int bj = 0; bj < 2; ++bj) { const size_t off = (size_t)(u.row0 + ai * 128 + wr * 64 + m * 16 + fr) * 3072 + (u.col0 + bj * 128 + wc * 32 + 8 * fq);
                    ga[m][bj] = *(const u32x2*)(G + off + u.aux * 1024); gb[m][bj] = ga[m][bj]; if (u.aux < 2) gb[m][bj] = *(const u32x2*)(G + off + (u.aux + 1) * 1024); }
#pragma unroll
            for (int m = 0; m < 4; ++m) { const int row = u.row0 + ai * 128 + wr * 64 + m * 16 + fr;
#pragma unroll
                for (int bj = 0; bj < 2; ++bj) { const int col0 = u.col0 + bj * 128 + wc * 32 + 8 * fq;
                    float g0[8]; gates_u8(ga[m][bj], g0);
                    if (u.aux < 2) { float g1[8]; gates_u8(gb[m][bj], g1);
#pragma unroll
                        for (int i = 0; i < 4; ++i) { acc[ai][bj][m][0][i] *= g0[i] * __builtin_amdgcn_rcpf(g1[i]); acc[ai][bj][m][1][i] *= g0[4 + i] * __builtin_amdgcn_rcpf(g1[4 + i]); }
                    } else { float y[8];
#pragma unroll
                        for (int i = 0; i < 4; ++i) { y[i] = acc[ai][bj][m][0][i] * g0[i] * (1.f / 255.f); y[4 + i] = acc[ai][bj][m][1][i] * g0[4 + i] * (1.f / 255.f); }
                        *(u32x4*)((bf16_t*)(c->ws + WS_Y) + (size_t)row * 1024 + col0) = pack8(y); } } }
            asm volatile("" ::: "memory"); } } };
struct SOut { const Ctx* c; pg8::TileOrder o;
    DEV bool next(int i, pg8::Unit& u) const { int pm, pn; if (!o.get(i, pm, pn)) return false;
        u.A = BFP(WS_Y) + (size_t)pm * 256 * 1024; u.Bt = BFP(c->wofs + W_OUT) + (size_t)pn * 256 * 1024; u.lda = 1024; u.kstepA = 128; u.row0 = pm * 256; u.col0 = pn * 256; u.aux = 0; u.keep = 0; u.gl = nullptr; u.gn = 0; return true; } };
template <int L> struct EOut { const Ctx* c;
    DEV void operator()(f32x4 (&acc)[2][2][4][2], const pg8::Unit& u, int wr, int wc, int fr, int fq) const {
        const float* basef = (u.row0 < RX ? c->p->in[I_X + c->z] + (size_t)u.row0 * DM : c->p->in[I_CTX + c->z] + (size_t)(u.row0 - RX) * DM) + u.col0;
        bf16_t* Hp = (bf16_t*)(c->ws + WS_H) + (size_t)u.row0 * DM + u.col0;
        const float* g1p = modp(c->ws, L, mod_idx(u.row0), 2) + u.col0 + wc * 32 + 8 * fq;
        f32x4 g[2][2];
#pragma unroll
        for (int bj = 0; bj < 2; ++bj) { g[bj][0] = *(const f32x4*)(g1p + bj * 128); g[bj][1] = *(const f32x4*)(g1p + bj * 128 + 4); }
        const int cl = wc * 32 + 8 * fq;
#pragma unroll
        for (int ai = 0; ai < 2; ++ai) { constexpr int mh = 0;
            u32x4 bq[4][2][2];
#pragma unroll
            for (int m2 = 0; m2 < 4; ++m2)
#pragma unroll
                for (int bj = 0; bj < 2; ++bj) { const unsigned off = (unsigned)((ai * 128 + wr * 64 + (mh * 2 + m2) * 16 + fr) * DM + cl + bj * 128);
                    if (L == 0) { bq[m2][bj][0] = *(const u32x4*)(basef + off); bq[m2][bj][1] = *(const u32x4*)(basef + off + 4); } else bq[m2][bj][0] = *(const u32x4*)(Hp + off); }
#pragma unroll
            for (int m2 = 0; m2 < 4; ++m2) { const int m = mh * 2 + m2; const int lr = ai * 128 + wr * 64 + m * 16 + fr; float ss = 0.f;
#pragma unroll
                for (int bj = 0; bj < 2; ++bj) { f32x4 b0, b1;
                    if (L == 0) { b0 = __builtin_bit_cast(f32x4, bq[m2][bj][0]); b1 = __builtin_bit_cast(f32x4, bq[m2][bj][1]); }
                    else { float t[8]; unpack8(bq[m2][bj][0], t); b0 = (f32x4){t[0], t[1], t[2], t[3]}; b1 = (f32x4){t[4], t[5], t[6], t[7]}; }
                    const f32x4 o0 = b0 + g[bj][0] * acc[ai][bj][m][0], o1 = b1 + g[bj][1] * acc[ai][bj][m][1];
                    u32x4 w; w.x = pk2(o0.x, o0.y); w.y = pk2(o0.z, o0.w); w.z = pk2(o1.x, o1.y); w.w = pk2(o1.z, o1.w);
                    *(u32x4*)(Hp + (unsigned)(lr * DM + cl + bj * 128)) = w;
                    ss += ((o0.x * o0.x + o0.y * o0.y) + (o0.z * o0.z + o0.w * o0.w)) + ((o1.x * o1.x + o1.y * o1.y) + (o1.z * o1.z + o1.w * o1.w)); }
                ss += __shfl_xor(ss, 16); ss += __shfl_xor(ss, 32);
                if (fq == 0) ((float*)(c->dout + DO_SSQH) + (size_t)u.row0 * 16 + (u.col0 >> 8) * 4)[(unsigned)(lr * 16 + wc)] = ss; }
            asm volatile("" ::: "memory"); } } };
constexpr int LDS_TT = 128 * 1024;
DEV void build_tile_table(const Ctx& c, const int* cnt) {
    int* tt = (int*)(c.lds + LDS_TT);
    for (int t = c.tid; t <= MAXTILES; t += 512) { int acc_t = 0, v = -1;
        for (int e = 0; e < NEXP; ++e) { const int nte = (cnt[e] + 255) >> 8; if (v < 0 && t < acc_t + nte) v = (e << 16) | (t - acc_t); acc_t += nte; }
        tt[t] = v; }
    __syncthreads();
}
template <int NPN> struct SMoe { const Ctx* c; const int* cnt; int G, cid;
    DEV bool next(int i, pg8::Unit& u) const {
        const int L = i * G + cid, tile = L / NPN, pn = L - tile * NPN;
        if (tile >= MAXTILES) return false;
        const int v = __builtin_amdgcn_readfirstlane(((const int*)(c->lds + LDS_TT))[tile]);
        if (v < 0) return false;
        const int e = v >> 16, j = v & 0xffff; const int ce = cnt[e];
        u.gl = (const int*)(c->ws + WS_LIST) + (size_t)e * R + j * 256; u.gn = min(256, ce - j * 256); u.keep = 0; u.aux = e; u.kstepA = 128;
        if (NPN == 2) { u.A = BFP(WS_FX); u.lda = 1024; u.Bt = BFP(c->wofs + W_GU) + ((size_t)e * 512 + pn * 256) * 1024; u.row0 = tile * 256; u.col0 = pn * 128; }
        else { u.A = BFP(WS_H1) + (size_t)tile * 256 * 256; u.lda = 256; u.Bt = BFP(c->wofs + W_DN) + ((size_t)e * 1024 + pn * 256) * 256; u.row0 = 0; u.col0 = pn * 256; }
        return true; } };
struct EMoe1 { const Ctx* c;
    DEV void operator()(f32x4 (&acc)[2][2][4][2], const pg8::Unit& u, int wr, int wc, int fr, int fq) const {
#pragma unroll
        for (int ai = 0; ai < 2; ++ai)
#pragma unroll
            for (int m = 0; m < 4; ++m) { const int slot = u.row0 + ai * 128 + wr * 64 + m * 16 + fr; const int col = u.col0 + wc * 32 + 8 * fq; float h[8];
#pragma unroll
                for (int i = 0; i < 4; ++i) { const float g0 = acc[ai][0][m][0][i], g1 = acc[ai][0][m][1][i];
                    h[i] = g0 * sigmoid_fast(g0) * acc[ai][1][m][0][i]; h[4 + i] = g1 * sigmoid_fast(g1) * acc[ai][1][m][1][i]; }
                *(u32x4*)((bf16_t*)(c->ws + WS_H1) + (size_t)slot * 256 + col) = pack8(h); } } };
struct EMoe2 { const Ctx* c;
    DEV void operator()(f32x4 (&acc)[2][2][4][2], const pg8::Unit& u, int wr, int wc, int fr, int fq) const {
        int tk[2][4]; float gt[2][4];
        const float* lgp = (const float*)(c->dout + DO_LGATE) + (u.gl - (const int*)(c->ws + WS_LIST));
#pragma unroll
        for (int ai = 0; ai < 2; ++ai)
#pragma unroll
            for (int m = 0; m < 4; ++m) { const int lr = ai * 128 + wr * 64 + m * 16 + fr; const bool ok = lr < u.gn; tk[ai][m] = ok ? u.gl[lr] : -1; gt[ai][m] = ok ? lgp[lr] : 0.f; }
#pragma unroll
        for (int ai = 0; ai < 2; ++ai)
#pragma unroll
            for (int m = 0; m < 4; ++m) { if (tk[ai][m] >= 0) {
#pragma unroll
                for (int bj = 0; bj < 2; ++bj) { const int col0 = u.col0 + bj * 128 + wc * 32 + 8 * fq; float y[8];
#pragma unroll
                    for (int i = 0; i < 4; ++i) { y[i] = acc[ai][bj][m][0][i] * gt[ai][m]; y[4 + i] = acc[ai][bj][m][1][i] * gt[ai][m]; }
                    *(u32x4*)((bf16_t*)(c->ws + WS_YTOK) + (size_t)tk[ai][m] * 1024 + col0) = pack8(y); } } } } };

#define LAS __attribute__((address_space(3)))
#define XB_TMO      128
#define XB_XCNT(j)  (256  + 64 * (j))
#define XB_XSUB(j)  (1280 + 64 * (j))
#define XB_XGEN(j)  (2304 + 64 * (j))
#define XB_TOP      3328
#define XB_TOPGEN   3392
#define XCD_BAR_WORDS 3456
#define XB_SPIN_CAP (1u << 18)
DEV unsigned xb_ld(unsigned* p)              { return __hip_atomic_load(p, __ATOMIC_RELAXED, __HIP_MEMORY_SCOPE_AGENT); }
DEV unsigned xb_add(unsigned* p, unsigned v) { return __hip_atomic_fetch_add(p, v, __ATOMIC_RELAXED, __HIP_MEMORY_SCOPE_AGENT); }
DEV unsigned xb_xcc_id() { return (unsigned)__builtin_amdgcn_s_getreg((3 << 11) | 20) & 0xFu; }
#define XB_SPIN(cond, bar) do { unsigned _sp = 0; while (cond) { __builtin_amdgcn_s_sleep(1); \
    if ((++_sp & 255u) == 0u) { if (xb_ld(&(bar)[XB_TMO])) break; if (_sp > XB_SPIN_CAP) { atomicAdd(&(bar)[XB_TMO], 1u); break; } } } } while (0)
struct XcdBarrier { unsigned* bar; unsigned x; volatile LAS unsigned* st; };
DEV XcdBarrier xcd_barrier_post(unsigned* bar, volatile LAS unsigned* st) {
    XcdBarrier b; b.bar = bar; b.x = xb_xcc_id(); b.st = st;
    if (threadIdx.x == 0) (void)xb_add(&bar[XB_XCNT(b.x)], 1u);
    return b;
}
DEV void xcd_barrier_complete(unsigned* bar, unsigned x, unsigned& nloc, unsigned& nx) {
    const unsigned G = gridDim.x * gridDim.y * gridDim.z;
    unsigned sum, cnt, mine, sp = 0u;
    for (;;) {
        sum = 0u; cnt = 0u; mine = 0u;
#pragma unroll
        for (unsigned j = 0; j < 16; ++j) { const unsigned c = xb_ld(&bar[XB_XCNT(j)]); sum += c; cnt += (c > 0u) ? 1u : 0u; mine = (j == x) ? c : mine; }
        if (sum == G) break;
        __builtin_amdgcn_s_sleep(1);
        if ((++sp & 255u) == 0u) { if (xb_ld(&bar[XB_TMO])) break; if (sp > XB_SPIN_CAP) { atomicAdd(&bar[XB_TMO], 1u); break; } }
    }
    nloc = mine > 0u ? mine : 1u; nx = cnt > 0u ? cnt : 1u;
}
DEV void xcd_barrier(const XcdBarrier& b) {
    asm volatile("s_waitcnt vmcnt(0)" ::: "memory");
    __syncthreads();
    if (threadIdx.x == 0) {
        unsigned* bar = b.bar;
        __builtin_amdgcn_s_waitcnt(0);
        unsigned nloc = b.st[0], nx = b.st[1];
        if (nloc == 0u) { xcd_barrier_complete(bar, b.x, nloc, nx); b.st[0] = nloc; b.st[1] = nx; }
        const unsigned old = xb_add(&bar[XB_XSUB(b.x)], 1u);
        const unsigned gen = old / nloc;
        if (old + 1u == (gen + 1u) * nloc) {
            __builtin_amdgcn_fence(__ATOMIC_RELEASE, "agent");
            asm volatile("s_waitcnt vmcnt(0)" ::: "memory");
            const unsigned og = xb_add(&bar[XB_TOP], 1u);
            const unsigned tg = og / nx;
            if (og + 1u == (tg + 1u) * nx) xb_add(&bar[XB_TOPGEN], 1u);
            else XB_SPIN(xb_ld(&bar[XB_TOPGEN]) == tg, bar);
            __builtin_amdgcn_fence(__ATOMIC_ACQUIRE, "agent");
            xb_add(&bar[XB_XGEN(b.x)], 1u);
            asm volatile("s_waitcnt vmcnt(0)" ::: "memory");
        } else {
            XB_SPIN(xb_ld(&bar[XB_XGEN(b.x)]) == gen, bar);
            __builtin_amdgcn_fence(__ATOMIC_ACQUIRE, "agent");
            asm volatile("s_waitcnt vmcnt(0)" ::: "memory");
        }
    }
    __syncthreads();
}

constexpr int STEPS = 9, NPROG = 1 + DEPTH * STEPS + 1;
constexpr int LDS_BARST = 131 * 1024;
DEV Ctx make_ctx(const Params& p, unsigned char* lds) {
    typedef __attribute__((address_space(1))) unsigned char gchar_t;
    gchar_t* ws_ = (gchar_t*)p.ws; gchar_t* do_ = (gchar_t*)p.out; int z_ = 0; int tid_ = threadIdx.x;
    asm volatile("" : "+s"(ws_), "+s"(do_), "+s"(z_)); asm volatile("" : "+v"(tid_));
    Ctx c; c.p = &p; c.z = z_; c.dummy = 0; c.wofs = WS_W; c.wre = WS_WRE; c.ws = (unsigned char*)ws_; c.dout = (unsigned char*)do_; c.lds = lds;
    c.tid = tid_; c.lane = c.tid & 63; c.wave = __builtin_amdgcn_readfirstlane(c.tid >> 6); c.G = gridDim.x + z_; c.gw = blockIdx.x * 8 + c.wave; c.NGW = c.G * 8; c.gtid = blockIdx.x * 512 + c.tid; c.NT = c.G * 512;
    return c;
}
DEV void tail_convert(const Ctx& c, int l, int part) {
    if (l != 0 || DEPTH < 2) return;
    const int nbusy = (R / 256) * 4 - 2 * c.G;
    if (nbusy <= 0 || nbusy >= c.G || 3 * c.G < (R / 256) * 4) { if (part == 1) { convert_weights(c, 1, (int)blockIdx.x, c.G, 0); convert_weights(c, 1, (int)blockIdx.x, c.G, 1); } return; }
    if ((int)blockIdx.x >= nbusy) convert_weights(c, 1, (int)blockIdx.x - nbusy, c.G - nbusy, part);
}
DEV void run_step(const Ctx& c0, int l, int s) {
    Ctx c = c0; c.wofs = (l == 0) ? WS_W : WS_W1; c.wre = WS_WRE + (size_t)l * 131072;
    const bool last = (l == DEPTH - 1); const int nrows = last ? RX : R;
    PG8_LAS unsigned char* L3 = (PG8_LAS unsigned char*)c.lds;
    if (s == 0) phase_rows(c, l, false);
    else if (s == 1) { SInproj S{&c}; S.o.init(R / 256, NIN / 256, c.G, (int)blockIdx.x); EInproj E{&c}; pg8::gemm_phase<EInproj, SInproj, false>(L3, 1024, S, E); }
    else if (s == 2) { SUp S{&c}; S.o.init(R / 256, 7, c.G, (int)blockIdx.x); EUp E{&c}; pg8::gemm_phase<EUp, SUp, false>(L3, 256, S, E); }
    else if (s == 3) phase_attn_fast(c, l);
    else if (s == 4) { SBranch S{&c}; S.o.init(nrows / 256, 4, c.G, (int)blockIdx.x); EBranch E{&c}; pg8::gemm_phase<EBranch, SBranch, false>(L3, 512, S, E); tail_convert(c, l, 0); }
    else if (s == 5) { SOut S{&c}; S.o.init(nrows / 256, 4, c.G, (int)blockIdx.x); if (l == 0) { EOut<0> E{&c}; pg8::gemm_phase<EOut<0>, SOut, false>(L3, 1024, S, E); } else { EOut<1> E{&c}; pg8::gemm_phase<EOut<1>, SOut, false>(L3, 1024, S, E); } tail_convert(c, l, 1); }
    else if (s == 6) phase_router(c, l);
    else if (s == 7) { const int* cnt = (const int*)(c.ws + WS_CNT) + l * 32; build_tile_table(c, cnt); SMoe<2> S{&c, cnt, c.G, (int)blockIdx.x}; EMoe1 E{&c}; pg8::gemm_phase<EMoe1, SMoe<2>, true>(L3, 1024, S, E); }
    else { const int* cnt = (const int*)(c.ws + WS_CNT) + l * 32; build_tile_table(c, cnt); SMoe<4> S{&c, cnt, c.G, (int)blockIdx.x}; EMoe2 E{&c}; pg8::gemm_phase<EMoe2, SMoe<4>, false>(L3, 256, S, E); }
}
#define SEAM(k) do { if ((k) + 1 < p.ph_hi) { XcdBarrier xb_; xb_.bar = (unsigned*)(p.ws + WS_BAR); xb_.x = xb_xcc_id(); xb_.st = (volatile LAS unsigned*)((LAS unsigned char*)lds + LDS_BARST); xcd_barrier(xb_); } } while (0)
#define STEP(k, body) do { if (p.ph_lo <= (k) && (k) < p.ph_hi) { { const Ctx c = make_ctx(p, lds); body; } SEAM(k); } } while (0)
template <int L> DEV void layer_steps(const Params& p, cg::grid_group& grid, unsigned char* lds) {
    STEP(1 + L * STEPS + 0, run_step(c, L, 0));
    STEP(1 + L * STEPS + 1, run_step(c, L, 1));
    STEP(1 + L * STEPS + 2, run_step(c, L, 2));
    STEP(1 + L * STEPS + 3, run_step(c, L, 3));
    STEP(1 + L * STEPS + 4, run_step(c, L, 4));
    STEP(1 + L * STEPS + 5, run_step(c, L, 5));
    STEP(1 + L * STEPS + 6, run_step(c, L, 6));
    STEP(1 + L * STEPS + 7, run_step(c, L, 7));
    STEP(1 + L * STEPS + 8, run_step(c, L, 8));
}
__global__ void __launch_bounds__(512, 2) mk(Params p) {
    extern __shared__ __attribute__((aligned(16))) unsigned char lds[];
    cg::grid_group grid = cg::this_grid();
    volatile LAS unsigned* st = (volatile LAS unsigned*)((LAS unsigned char*)lds + LDS_BARST);
    if (threadIdx.x < 2) st[threadIdx.x] = 0u;
    __syncthreads();
    (void)xcd_barrier_post((unsigned*)(p.ws + WS_BAR), st);
    grid.sync();
    STEP(0, { phase_p0(c); convert_weights(c, 0, (int)blockIdx.x, c.G, -1); });
    layer_steps<0>(p, grid, lds);
    layer_steps<1>(p, grid, lds);
    STEP(NPROG - 1, phase_rows(c, DEPTH, true));
}

constexpr int LDS_BYTES = 132 * 1024;
extern "C" void kernel_launch(void* const* d_in, const int* in_sizes, int n_in, void* d_out, int out_size, void* d_ws, size_t ws_size, hipStream_t stream) {
    static int grid = 0;
    if (grid == 0) {
        if (n_in != 27 || out_size != RX * DM || ws_size < WS_NEED) { fprintf(stderr, "kernel_launch: unexpected shapes n_in %d out %d ws %zu\n", n_in, out_size, ws_size); grid = -1; return; }
        int dev = 0, cus = 0, per_cu = 0;
        hipGetDevice(&dev); hipDeviceGetAttribute(&cus, hipDeviceAttributeMultiprocessorCount, dev);
        hipFuncSetAttribute((const void*)mk, hipFuncAttributeMaxDynamicSharedMemorySize, LDS_BYTES);
        hipOccupancyMaxActiveBlocksPerMultiprocessor(&per_cu, (const void*)mk, 512, LDS_BYTES);
        if (per_cu < 1) { fprintf(stderr, "kernel_launch: occupancy query says %d\n", per_cu); grid = -1; return; }
        grid = cus;
    }
    if (grid < 0) return;
    Params p{};
    for (int i = 0; i < 27; ++i) p.in[i] = (const float*)d_in[i];
    p.out = (float*)d_out; p.ws = (unsigned char*)d_ws;
    if (hipMemsetAsync((unsigned char*)d_ws + WS_BAR, 0, XCD_BAR_WORDS * 4, stream) != hipSuccess) { fprintf(stderr, "kernel_launch: memset failed\n"); return; }
    p.ph_lo = 0; p.ph_hi = NPROG;
    void* args[] = {&p};
    hipError_t e = hipLaunchCooperativeKernel((const void*)mk, dim3(grid), dim3(512), args, LDS_BYTES, stream);
    if (e != hipSuccess) fprintf(stderr, "cooperative launch failed: %s\n", hipGetErrorString(e));
}
```

```cpp
#include <hip/hip_runtime.h>
#include <hip/hip_cooperative_groups.h>
#include <cstdio>
#include <cstdint>
namespace cg = cooperative_groups;

#ifndef MK_ONE_LAUNCH
#define MK_ONE_LAUNCH 1
#endif

#define DEV __device__ __forceinline__
typedef unsigned short bf16_t;
typedef unsigned u32x4 __attribute__((ext_vector_type(4)));
typedef unsigned u32x2 __attribute__((ext_vector_type(2)));
typedef float f32x4 __attribute__((ext_vector_type(4)));

constexpr int DM = 1024, NB = 8, SEQ = 4096, LC = 256, DEPTH = 2;
constexpr int RX = NB * SEQ, RC = NB * LC, R = RX + RC;
constexpr int NIN = 5120;
constexpr int NEXP = 32, EFF = 256;
constexpr int MAXTILES = 304;
constexpr float EPS = 1e-6f;
constexpr float LOG2E = 1.4426950408889634f;
constexpr float SCALE_A = 0.125f * LOG2E;
constexpr float SCALE_B = 0.10206207261596577f * LOG2E;

constexpr int C_QA = 0, C_KA = 512, C_VA = 640, C_CQ = 768, C_CKV = 1024, C_U = 1280, C_G = 1792, C_KR = 4864, C_END = 4896;

constexpr size_t MiB = 1ull << 20;
constexpr size_t WS_MOD = 0;
constexpr size_t WS_TABA = 448 * 1024;
constexpr size_t WS_TABB = 460 * 1024;
constexpr size_t WS_CNT = 512 * 1024;
constexpr size_t WS_WRE = 1 * MiB;
constexpr size_t WS_BAR = 576 * 1024;
constexpr size_t WS_SSQ = 6 * MiB + 512 * 1024;
constexpr size_t WS_GATE = 1 * MiB + 512 * 1024;
constexpr size_t WS_LIST = 2 * MiB;
constexpr size_t WS_W = 8 * MiB;
constexpr size_t WS_W1 = 140 * MiB;
constexpr size_t W_IN = 0, W_UQ = W_IN + (size_t)NIN * 1024 * 2, W_UKV = W_UQ + 768 * 256 * 2, W_BA = W_UKV + 1024 * 256 * 2,
                 W_BB = W_BA + 1024 * 512 * 2, W_BC = W_BB + 1024 * 512 * 2, W_OUT = W_BC + 1024 * 512 * 2,
                 W_GU = W_OUT + 1024 * 1024 * 2, W_DN = W_GU + (size_t)NEXP * 512 * 1024 * 2, W_TOTAL = W_DN + (size_t)NEXP * 1024 * 256 * 2;
static_assert(W_TOTAL <= 64 * MiB, "weights");
constexpr size_t WS_H = 72 * MiB;
constexpr size_t WS_XN = 208 * MiB;
constexpr size_t WS_QA = 276 * MiB;
constexpr size_t WS_QB = 310 * MiB;
constexpr size_t WS_KNB = 361 * MiB;
constexpr size_t WS_VB = 395 * MiB;
constexpr size_t WS_CQ = 429 * MiB;
constexpr size_t WS_CKV = 446 * MiB;
constexpr size_t WS_POOL = 429 * MiB;
constexpr size_t WS_U = 463 * MiB;
constexpr size_t WS_YTOK = 310 * MiB;
constexpr size_t WS_H1 = 446 * MiB;
constexpr size_t WS_Y = 361 * MiB;
constexpr size_t WS_FX = 361 * MiB;
constexpr size_t WS_NEED = 512 * MiB;
constexpr size_t DO_G = 0;
constexpr size_t DO_KA = (size_t)R * 3072;
constexpr size_t DO_VA = DO_KA + (size_t)R * 128 * 2;
constexpr size_t DO_KR = DO_VA + (size_t)R * 128 * 2;
constexpr size_t DO_SSQH = DO_KR + (size_t)R * 32 * 2;
constexpr size_t DO_LGATE = DO_SSQH + (size_t)R * 16 * 4;
static_assert(DO_LGATE + (size_t)NEXP * R * 4 <= (size_t)RX * DM * 4, "d_out scratch");

struct Params { const float* in[27]; float* out; unsigned char* ws; int ph_lo, ph_hi; };
enum { I_X = 0, I_C, I_CTX, I_CCTX, I_WMOD, I_BMOD, I_GMIX, I_GFFN, I_WIN, I_SINK, I_QNG, I_WUQ, I_KVNG, I_WUKV, I_WPOOL, I_PSCALE,
       I_WBA, I_WBB, I_WBC, I_WOUT, I_WRG, I_BRG, I_WRE, I_BRE, I_WGU, I_WDN, I_FING };

DEV float bf2f(bf16_t v) { return __uint_as_float((unsigned)v << 16); }
DEV unsigned f2bf(float f) { unsigned u = __float_as_uint(f); return (u + 0x7fffu + ((u >> 16) & 1u)) >> 16; }
DEV unsigned pk2(float lo, float hi) { unsigned r; asm("v_cvt_pk_bf16_f32 %0, %1, %2" : "=v"(r) : "v"(lo), "v"(hi)); return r; }
DEV void unpack8(const u32x4 w, float (&f)[8]) {
    f[0] = __uint_as_float(w.x << 16); f[1] = __uint_as_float(w.x & 0xffff0000u); f[2] = __uint_as_float(w.y << 16); f[3] = __uint_as_float(w.y & 0xffff0000u);
    f[4] = __uint_as_float(w.z << 16); f[5] = __uint_as_float(w.z & 0xffff0000u); f[6] = __uint_as_float(w.w << 16); f[7] = __uint_as_float(w.w & 0xffff0000u);
}
DEV u32x4 pack8(const float (&f)[8]) { u32x4 w; w.x = pk2(f[0], f[1]); w.y = pk2(f[2], f[3]); w.z = pk2(f[4], f[5]); w.w = pk2(f[6], f[7]); return w; }
DEV float wave_sum(float v) {
#pragma unroll
    for (int o = 1; o < 64; o <<= 1) v += __shfl_xor(v, o);
    return v;
}
DEV float sigmoidf_(float x) { return 1.f / (1.f + __expf(-x)); }
DEV float sigmoid_fast(float x) { return __builtin_amdgcn_rcpf(1.f + __builtin_amdgcn_exp2f(x * (-LOG2E))); }
DEV int mod_idx(int row) { return row < RX ? (row >> 12) : 8; }
DEV const float* modp(const unsigned char* ws, int l, int mb, int chunk) { return (const float*)(ws + WS_MOD) + ((size_t)(l * 9 + mb) * 6 + chunk) * 1024; }

struct Ctx {
    const Params* p; unsigned char* ws; unsigned char* dout; unsigned char* lds; int z; int dummy; size_t wofs, wre;
    int tid, lane, wave, G, gw, NGW, gtid, NT;
};

DEV void epi_inproj(const Ctx& c, int row, int col0, const float (&vin)[8], const f32x4 (&tb)[2]) {
    float v[8];
#pragma unroll
    for (int i = 0; i < 8; ++i) v[i] = vin[i];
    const bool xrow = row < RX;
    if (col0 < C_VA) {
        const bool isq = col0 < C_KA;
        const int w0 = col0 & 63;
        if (xrow) {
#pragma unroll
            for (int i = 0; i < 4; ++i) { const float cx = tb[i >> 1][2 * (i & 1)], sx = tb[i >> 1][2 * (i & 1) + 1]; const float a = v[2 * i], b = v[2 * i + 1]; v[2 * i] = a * cx - b * sx; v[2 * i + 1] = a * sx + b * cx; }
        }
        if (isq) {
#pragma unroll
            for (int i = 0; i < 8; ++i) v[i] *= SCALE_A;
            *(u32x4*)((bf16_t*)(c.ws + WS_QA) + (size_t)row * 512 + col0) = pack8(v);
        } else *(u32x4*)((bf16_t*)(c.dout + DO_KA) + (size_t)row * 128 + (col0 - C_KA)) = pack8(v);
    } else if (col0 < C_CQ) {
        *(u32x4*)((bf16_t*)(c.dout + DO_VA) + (size_t)row * 128 + (col0 - C_VA)) = pack8(v);
    } else if (col0 < C_CKV) {
        *(u32x4*)((bf16_t*)(c.ws + WS_CQ) + (size_t)row * 256 + (col0 - C_CQ)) = pack8(v);
    } else if (col0 < C_U) {
        *(u32x4*)((bf16_t*)(c.ws + WS_CKV) + (size_t)row * 256 + (col0 - C_CKV)) = pack8(v);
    } else if (col0 < C_G) {
        *(u32x4*)((bf16_t*)(c.ws + WS_U) + (size_t)row * 512 + (col0 - C_U)) = pack8(v);
    } else if (col0 < C_KR) {
        unsigned q[8];
#pragma unroll
        for (int i = 0; i < 8; ++i) { const float s = __builtin_amdgcn_rcpf(1.f + __builtin_amdgcn_exp2f(v[i] * (-LOG2E))) * 255.f + 0.5f; q[i] = max((unsigned)s, 1u); }
        u32x2 w; w.x = q[0] | (q[1] << 8) | (q[2] << 16) | (q[3] << 24); w.y = q[4] | (q[5] << 8) | (q[6] << 16) | (q[7] << 24);
        *(u32x2*)(c.dout + DO_G + (size_t)row * 3072 + (col0 - C_G)) = w;
    } else if (col0 < C_END) {
        const int w0 = col0 - C_KR;
        if (xrow) {
#pragma unroll
            for (int i = 0; i < 4; ++i) { const float cx = tb[i >> 1][2 * (i & 1)], sx = tb[i >> 1][2 * (i & 1) + 1]; const float a = v[2 * i], b = v[2 * i + 1]; v[2 * i] = a * cx - b * sx; v[2 * i + 1] = a * sx + b * cx; }
        }
        *(u32x4*)((bf16_t*)(c.dout + DO_KR) + (size_t)row * 32 + w0) = pack8(v);
    }
}
DEV const f32x4* inproj_tab(const Ctx& c, int row, int col0) {
    const int pos = row & (SEQ - 1);
    if (col0 < C_VA) { const int p0 = (col0 & 63) >> 1; const int pp = (p0 < 16) ? (pos >> 6) : (pos & 63); return (const f32x4*)((const float2*)(c.ws + WS_TABA) + pp * 16 + (p0 & 15)); }
    const int p0 = (col0 - C_KR) >> 1; const int pp = (p0 < 8) ? (pos >> 6) : (pos & 63); return (const f32x4*)((const float2*)(c.ws + WS_TABB) + pp * 8 + (p0 & 7));
}
DEV void epi_upq(const Ctx& c, int row, int col0, const float (&vin)[8], float rs) {
    float v[8];
#pragma unroll
    for (int i = 0; i < 8; ++i) v[i] = vin[i] * rs;
    const int w0 = col0 % 96;
    if (w0 >= 64 && row < RX) {
        const int pos = row & (SEQ - 1); const int p0 = (w0 - 64) >> 1; const int pp = (p0 < 8) ? (pos >> 6) : (pos & 63);
        const float2* tab = (const float2*)(c.ws + WS_TABB) + pp * 8 + (p0 & 7);
#pragma unroll
        for (int i = 0; i < 4; ++i) { const float2 cs = tab[i]; const float a = v[2 * i], b = v[2 * i + 1]; v[2 * i] = a * cs.x - b * cs.y; v[2 * i + 1] = a * cs.y + b * cs.x; }
    }
    *(u32x4*)((bf16_t*)(c.ws + WS_QB) + (size_t)row * 768 + col0) = pack8(v);
}
DEV void epi_upkv(const Ctx& c, int row, int col0, const float (&vin)[8], float rs) {
    float v[8];
#pragma unroll
    for (int i = 0; i < 8; ++i) v[i] = vin[i] * rs;
    const int h = col0 >> 7, w0 = col0 & 127;
    if (w0 < 64) *(u32x4*)((bf16_t*)(c.ws + WS_KNB) + (size_t)row * 512 + h * 64 + w0) = pack8(v);
    else *(u32x4*)((bf16_t*)(c.ws + WS_VB) + (size_t)row * 512 + h * 64 + (w0 - 64)) = pack8(v);
}
DEV void load_gates8(const Ctx& c, int row, int col, float (&g)[8]) {
    const u32x2 w = *(const u32x2*)(c.dout + DO_G + (size_t)row * 3072 + col);
    g[0] = (float)(w.x & 255u); g[1] = (float)((w.x >> 8) & 255u); g[2] = (float)((w.x >> 16) & 255u); g[3] = (float)(w.x >> 24);
    g[4] = (float)(w.y & 255u); g[5] = (float)((w.y >> 8) & 255u); g[6] = (float)((w.y >> 16) & 255u); g[7] = (float)(w.y >> 24);
}
namespace pg8 {
#define PG8_LAS __attribute__((address_space(3)))
typedef short bf16x8 __attribute__((ext_vector_type(8)));
constexpr int BM = 256, BK = 64, HALF = 128, HTB = HALF * BK * 2, STAGE_BYTES = 8 * HTB, NXCD = 8, WGM = 8;
DEV int lds_byte(int r, int c) { const int st = (r >> 4) * 2 + (c >> 5), rr = r & 15, cc = c & 31, ob = rr * 64 + cc * 2; return st * 1024 + (ob ^ (((ob >> 9) & 1) << 5)); }
DEV void stage_rc(int b, int& R_, int& C_) { const int st = b / 1024, sb = b % 1024, swz = sb ^ (((sb >> 9) & 1) << 5); R_ = (st >> 1) * 16 + swz / 64; C_ = (st & 1) * 32 + (swz % 64) / 2; }
DEV int perm32(int rho) { const int n = rho >> 4, i = rho & 15; return 8 * (i >> 2) + 4 * n + (i & 3); }

struct Unit { const bf16_t* A; const bf16_t* Bt; int lda; int kstepA; int row0, col0; int aux; int keep; const int* gl; int gn; };

struct TileOrder { int nM, nN, nwg, G, c;
    DEV void init(int nM_, int nN_, int G_, int c_) { nM = nM_; nN = nN_; nwg = nM * nN; G = G_; c = c_; }
    DEV bool get(int i, int& pm, int& pn) const {
        const long L = (long)i * G + c; if (L >= nwg) return false;
        int wgid = (int)L; { const int q = nwg / NXCD, r = nwg % NXCD, xcd = wgid % NXCD, off = wgid / NXCD; wgid = (xcd < r ? xcd * (q + 1) : r * (q + 1) + (xcd - r) * q) + off; }
        const int nig = WGM * nN, gid = wgid / nig, fm = gid * WGM, gsz = (nM - fm) < WGM ? (nM - fm) : WGM;
        pm = fm + ((wgid % nig) % gsz); pn = (wgid % nig) / gsz; return true; } };

template <bool GATHER>
DEV void calc_voA(const Unit& u, unsigned (&vo)[2][2], const int (&Rr)[2], const int (&Cc)[2]) {
#pragma unroll
    for (int h = 0; h < 2; ++h)
#pragma unroll
        for (int i = 0; i < 2; ++i) { const int r = h * HALF + Rr[i]; int srow = r;
            if (GATHER) srow = (r < u.gn) ? (u.gl[r] >> 1) : 0;
            vo[h][i] = (unsigned)(srow * u.lda + Cc[i]) * 2u; }
}

template <class Epi, class Sched, bool GATHER>
DEV void gemm_phase(PG8_LAS unsigned char* lds, const int K, const Sched& S, const Epi& E) {
    const int tid = threadIdx.x, wid = __builtin_amdgcn_readfirstlane(tid >> 6), lane = tid & 63, wr = wid >> 2, wc = wid & 3, fr = lane & 15, fq = lane >> 4;
    const int nt = K / BK;
    int Rr[2], Cc[2]; unsigned voffB[2];
#pragma unroll
    for (int i = 0; i < 2; ++i) { stage_rc(tid * 16 + i * 8192, Rr[i], Cc[i]); const int Rb = (Rr[i] & ~31) + perm32(Rr[i] & 31); voffB[i] = (unsigned)(Rb * K + Cc[i]) * 2u; }
    const size_t kstep = (size_t)(BK * 2);
    const size_t hstepB = (size_t)HALF * K * 2;
    const unsigned ldsw = (unsigned)wid * 1024u;
    const int aoff = lds_byte(wr * 64 + fr, fq * 8), boff = lds_byte(wc * 32 + fr, fq * 8);
#define PG8_SA(b, h) (((b) * 2 + (h)) * HTB)
#define PG8_SB(b, h) ((4 + (b) * 2 + (h)) * HTB)
#define PG8_STAGE(bufoff, gbase, voff) do { _Pragma("unroll") for (int _i = 0; _i < 2; ++_i) \
        __builtin_amdgcn_global_load_lds((const unsigned*)((const char*)(gbase) + (voff)[_i]), (PG8_LAS unsigned*)(lds + (bufoff) + ldsw + _i * 8192), 16, 0, 0); } while (0)
#define PG8_STAGE_A(bufoff, gbase, h, lda_, vo_) do { _Pragma("unroll") for (int _i = 0; _i < 2; ++_i) { \
        const unsigned _o = GATHER ? (vo_)[h][_i] : (unsigned)(((h) * HALF + Rr[_i]) * (lda_) + Cc[_i]) * 2u; \
        __builtin_amdgcn_global_load_lds((const unsigned*)((const char*)(gbase) + _o), (PG8_LAS unsigned*)(lds + (bufoff) + ldsw + _i * 8192), 16, 0, 0); } } while (0)
#define PG8_LDA(dst, b, h) do { _Pragma("unroll") for (int m = 0; m < 4; ++m) _Pragma("unroll") for (int k = 0; k < 2; ++k) dst[m][k] = *(const PG8_LAS bf16x8*)(lds + PG8_SA(b, h) + aoff + m * 2048 + k * 1024); } while (0)
#define PG8_LDB(dst, b, h) do { _Pragma("unroll") for (int n = 0; n < 2; ++n) _Pragma("unroll") for (int k = 0; k < 2; ++k) dst[n][k] = *(const PG8_LAS bf16x8*)(lds + PG8_SB(b, h) + boff + n * 2048 + k * 1024); } while (0)
#define PG8_MMA(ai, bj, At, Bt) do { __builtin_amdgcn_s_setprio(1); _Pragma("unroll") for (int m = 0; m < 4; ++m) _Pragma("unroll") for (int n = 0; n < 2; ++n) _Pragma("unroll") for (int k = 0; k < 2; ++k) \
        acc[ai][bj][m][n] = __builtin_amdgcn_mfma_f32_16x16x32_bf16(Bt[n][k], At[m][k], acc[ai][bj][m][n], 0, 0, 0); __builtin_amdgcn_s_setprio(0); } while (0)
#define PG8_WAIT_V(n) asm volatile("s_waitcnt vmcnt(" #n ")" ::: "memory")
#define PG8_WAIT_L(n) asm volatile("s_waitcnt lgkmcnt(" #n ")" ::: "memory")
#define PG8_BAR __builtin_amdgcn_s_barrier()
#define PG8_SCHED __builtin_amdgcn_sched_barrier(0)
    Unit cur, nxt; int ui = 0;
    if (!S.next(0, cur)) return;
    f32x4 acc[2][2][4][2];
#pragma unroll
    for (int a = 0; a < 2; ++a)
#pragma unroll
        for (int b = 0; b < 2; ++b)
#pragma unroll
            for (int m = 0; m < 4; ++m)
#pragma unroll
                for (int n = 0; n < 2; ++n) acc[a][b][m][n] = (f32x4){0.f, 0.f, 0.f, 0.f};
    bf16x8 At[4][2], B0[2][2], B1[2][2];
    unsigned voA[2][2], nvoA[2][2];
    if (GATHER) calc_voA<GATHER>(cur, voA, Rr, Cc);
    const char* cA = (const char*)cur.A; const char* cB = (const char*)cur.Bt;
    PG8_STAGE(PG8_SB(0, 0), cB, voffB); PG8_STAGE(PG8_SB(0, 1), cB + hstepB, voffB); PG8_STAGE_A(PG8_SA(0, 0), cA, 0, cur.lda, voA); PG8_STAGE_A(PG8_SA(0, 1), cA, 1, cur.lda, voA);
    if (wr == 1) PG8_BAR;
    PG8_WAIT_V(2); PG8_BAR;
    PG8_STAGE(PG8_SB(1, 0), cB + kstep, voffB); PG8_STAGE_A(PG8_SA(1, 0), cA + cur.kstepA, 0, cur.lda, voA); PG8_STAGE(PG8_SB(1, 1), cB + hstepB + kstep, voffB);
    PG8_WAIT_V(6); PG8_BAR;
    for (;;) {
        const bool has_next = S.next(ui + 1, nxt);
        const char* nA = has_next ? (const char*)nxt.A : cA; const char* nB = has_next ? (const char*)nxt.Bt : cB;
        if (GATHER && has_next) calc_voA<GATHER>(nxt, nvoA, Rr, Cc);
        else if (GATHER) {
#pragma unroll
            for (int h = 0; h < 2; ++h)
#pragma unroll
                for (int i = 0; i < 2; ++i) nvoA[h][i] = voA[h][i]; }
#pragma unroll 1
        for (int t = 0; t < nt; t += 2) {
            const bool last = (t == nt - 2);
            const char* a1 = cA + (size_t)(t + 1) * cur.kstepA;
            const char* a2 = last ? nA : cA + (size_t)(t + 2) * cur.kstepA; const char* b2 = last ? nB : cB + (size_t)(t + 2) * kstep;
            const char* a3 = a2 + ((last && has_next) ? nxt.kstepA : cur.kstepA); const char* b3 = b2 + kstep;
            unsigned v2[2][2]; const int lda2 = (last && has_next) ? nxt.lda : cur.lda;
            if (GATHER) {
#pragma unroll
                for (int h = 0; h < 2; ++h)
#pragma unroll
                    for (int i = 0; i < 2; ++i) v2[h][i] = last ? nvoA[h][i] : voA[h][i]; }
            PG8_LDB(B0, 0, 0); PG8_LDB(B1, 0, 1); PG8_SCHED; PG8_LDA(At, 0, 0); PG8_STAGE_A(PG8_SA(1, 1), a1, 1, cur.lda, voA);
            PG8_WAIT_V(8); PG8_WAIT_L(0); PG8_BAR; PG8_MMA(0, 0, At, B0); PG8_MMA(0, 1, At, B1); PG8_BAR; PG8_SCHED;
            PG8_LDA(At, 0, 1); PG8_STAGE(PG8_SB(0, 0), b2, voffB); PG8_STAGE(PG8_SB(0, 1), b2 + hstepB, voffB); PG8_STAGE_A(PG8_SA(0, 0), a2, 0, lda2, v2);
            PG8_WAIT_V(8); PG8_WAIT_L(0); PG8_BAR; PG8_MMA(1, 0, At, B0); PG8_MMA(1, 1, At, B1); PG8_BAR; PG8_SCHED;
            PG8_LDB(B0, 1, 0); PG8_LDB(B1, 1, 1); PG8_SCHED; PG8_LDA(At, 1, 0); PG8_STAGE_A(PG8_SA(0, 1), a2, 1, lda2, v2);
            PG8_WAIT_V(8); PG8_WAIT_L(0); PG8_BAR; PG8_MMA(0, 0, At, B0); PG8_MMA(0, 1, At, B1); PG8_BAR; PG8_SCHED;
            PG8_LDA(At, 1, 1); PG8_STAGE(PG8_SB(1, 0), b3, voffB); PG8_STAGE(PG8_SB(1, 1), b3 + hstepB, voffB); PG8_STAGE_A(PG8_SA(1, 0), a3, 0, lda2, v2);
            PG8_WAIT_V(8); PG8_WAIT_L(0); PG8_BAR; PG8_MMA(1, 0, At, B0); PG8_MMA(1, 1, At, B1); PG8_BAR; PG8_SCHED;
        }
        if (wr == 0) PG8_BAR;
        { int fr_ = fr, fq_ = fq, wr_ = wr, wc_ = wc;
          asm volatile("" : "+v"(fr_), "+v"(fq_)); asm volatile("" : "+s"(wr_), "+s"(wc_));
          E(acc, cur, wr_, wc_, fr_, fq_); }
        if (!has_next) break;
        if (!cur.keep) {
#pragma unroll
            for (int a = 0; a < 2; ++a)
#pragma unroll
                for (int b = 0; b < 2; ++b)
#pragma unroll
                    for (int m = 0; m < 4; ++m)
#pragma unroll
                        for (int n = 0; n < 2; ++n) acc[a][b][m][n] = (f32x4){0.f, 0.f, 0.f, 0.f}; }
        cur = nxt; cA = nA; cB = nB; ++ui;
        if (GATHER) {
#pragma unroll
            for (int h = 0; h < 2; ++h)
#pragma unroll
                for (int i = 0; i < 2; ++i) voA[h][i] = nvoA[h][i]; }
        if (wr == 1) PG8_BAR;
    }
    PG8_WAIT_V(0);
    PG8_BAR;
#undef PG8_SA
#undef PG8_SB
#undef PG8_STAGE
#undef PG8_STAGE_A
#undef PG8_LDA
#undef PG8_LDB
#undef PG8_MMA
#undef PG8_WAIT_V
#undef PG8_WAIT_L
#undef PG8_BAR
#undef PG8_SCHED
}
template <class F> struct Epi8 { F f;
    DEV void operator()(f32x4 (&acc)[2][2][4][2], const Unit& u, int wr, int wc, int fr, int fq) const {
#pragma unroll
        for (int ai = 0; ai < 2; ++ai)
#pragma unroll
            for (int m = 0; m < 4; ++m) { const int row = u.row0 + ai * HALF + wr * 64 + m * 16 + fr;
#pragma unroll
                for (int bj = 0; bj < 2; ++bj) { const int col0 = u.col0 + bj * HALF + wc * 32 + 8 * fq;
                    float v[8]; const f32x4 x0 = acc[ai][bj][m][0], x1 = acc[ai][bj][m][1];
                    v[0] = x0[0]; v[1] = x0[1]; v[2] = x0[2]; v[3] = x0[3]; v[4] = x1[0]; v[5] = x1[1]; v[6] = x1[2]; v[7] = x1[3];
                    f(u, row, col0, v); asm volatile("" ::: "memory"); } } } };
}

DEV void phase_p0(const Ctx& c) {
    const Params& p = *c.p;
    if (blockIdx.x == 0 && c.tid < 64) ((int*)(c.ws + WS_CNT))[c.tid] = 0;
    if (c.gtid < 64 * 16) { const int pos = c.gtid >> 4, i = c.gtid & 15; const float inv = powf(10000.f, -(float)(2 * i) / 32.f); const float ang = (float)pos * inv;
        ((float2*)(c.ws + WS_TABA))[c.gtid] = make_float2(cosf(ang), sinf(ang)); }
    else if (c.gtid < 64 * 16 + 64 * 8) { const int g = c.gtid - 1024; const int pos = g >> 3, i = g & 7; const float inv = powf(10000.f, -(float)(2 * i) / 16.f); const float ang = (float)pos * inv;
        ((float2*)(c.ws + WS_TABB))[g] = make_float2(cosf(ang), sinf(ang)); }
    float* sc = (float*)c.lds;
    float* red = sc + 9 * 1024;
    for (int i = c.tid; i < 9 * 1024; i += 512) { const float v = (i < 8 * 1024) ? p.in[I_C + c.z][i] : p.in[I_CCTX + c.z][i - 8 * 1024]; sc[i] = v * sigmoidf_(v); }
    __syncthreads();
    for (int item = blockIdx.x; item < 256; item += c.G) {
        const int l = item / 128, nb = item % 128, n = nb * 48 + (c.lane < 48 ? c.lane : 47);
        const float* W = p.in[I_WMOD + c.z] + (size_t)l * 1024 * 6144 + n;
        float acc[9];
#pragma unroll
        for (int j = 0; j < 9; ++j) acc[j] = 0.f;
#pragma unroll 1
        for (int k0 = c.wave * 128; k0 < c.wave * 128 + 128; k0 += 32) { float w[32];
#pragma unroll
            for (int i = 0; i < 32; ++i) w[i] = W[(size_t)(k0 + i) * 6144];
#pragma unroll
            for (int i = 0; i < 32; ++i)
#pragma unroll
                for (int j = 0; j < 9; ++j) acc[j] += sc[j * 1024 + k0 + i] * w[i]; }
#pragma unroll
        for (int j = 0; j < 9; ++j) red[(c.wave * 9 + j) * 64 + c.lane] = acc[j];
        __syncthreads();
        for (int i = c.tid; i < 576; i += 512) { const int j = i >> 6, ln = i & 63; float s = 0.f;
#pragma unroll
            for (int w = 0; w < 8; ++w) s += red[(w * 9 + j) * 64 + ln];
            if (ln < 48) ((float*)(c.ws + WS_MOD))[(size_t)(l * 9 + j) * 6144 + nb * 48 + ln] = s + p.in[I_BMOD + c.z][l * 6144 + nb * 48 + ln]; }
        __syncthreads();
    }
}

DEV void tr_item(const float* W, int ldn, int K, int k0, int nsrc0, bf16_t* WT, int d0, float* scr, int lane, const float* kscale, bool zero) {
#pragma unroll 8
    for (int i = 0; i < 32; ++i) { const int kk = 2 * i + (lane >> 5); float v = 0.f;
        if (!zero) { v = W[(size_t)(k0 + kk) * ldn + nsrc0 + (lane & 31)]; if (kscale) v *= kscale[k0 + kk]; }
        scr[kk * 33 + (lane & 31)] = v; }
    __builtin_amdgcn_s_waitcnt(0xc07f); __builtin_amdgcn_wave_barrier();
    const int ch = lane & 7;
#pragma unroll
    for (int j = 0; j < 4; ++j) { const int n = (lane >> 3) + 8 * j; const float* s = scr + (8 * ch) * 33 + n;
        u32x4 o; o.x = pk2(s[0], s[33]); o.y = pk2(s[2 * 33], s[3 * 33]); o.z = pk2(s[4 * 33], s[5 * 33]); o.w = pk2(s[6 * 33], s[7 * 33]);
        *(u32x4*)(WT + (size_t)(d0 + n) * K + k0 + 8 * ch) = o; }
    __builtin_amdgcn_s_waitcnt(0xc07f); __builtin_amdgcn_wave_barrier();
}
constexpr int CV_IN = 8 * 20, CV_UQ = 2 * 3, CV_UKV = 2 * 4, CV_BR = 4 * 4, CV_OUT = 8 * 4, CV_GU = NEXP * 8 * 2, CV_DN = NEXP * 2 * 4;
constexpr int CV_NITEMS = CV_IN + CV_UQ + CV_UKV + 2 * CV_BR + CV_OUT + CV_GU + CV_DN, CV_SPLIT = 600;
DEV void tr_wg_item(const Ctx& c, const float* W, int ldn, int K, int k0, int d0, int kind, bf16_t* WT, const float* kscale) {
    float* tile = (float*)c.lds;
    const int r8 = c.tid >> 6, c4 = (c.tid & 63) * 4;
    const int dblk = d0 + (c4 & ~31); int sblk;
    if (kind == 1) sblk = (dblk < C_U) ? dblk : (dblk < C_KR) ? dblk + 32 : (dblk < C_END) ? dblk - C_KR + 1280 : -1;
    else if (kind == 2) { const int pn = dblk >> 8, w = dblk & 255; sblk = (w < 128) ? (128 * pn + w) : (256 + 128 * pn + (w - 128)); }
    else sblk = dblk;
    f32x4 v[16];
#pragma unroll
    for (int it = 0; it < 16; ++it) { const int kk = it * 8 + r8; v[it] = (f32x4){0.f, 0.f, 0.f, 0.f};
        if (sblk >= 0) v[it] = *(const f32x4*)(W + (size_t)(k0 + kk) * ldn + sblk + (c4 & 31)); }
    __syncthreads();
#pragma unroll
    for (int it = 0; it < 16; ++it) { const int kk = it * 8 + r8; f32x4 t = v[it]; if (kscale) t = t * kscale[k0 + kk];
        float* d = tile + kk * 257 + c4; d[0] = t.x; d[1] = t.y; d[2] = t.z; d[3] = t.w; }
    __syncthreads();
#pragma unroll
    for (int j = 0; j < 8; ++j) { const int idx = j * 512 + c.tid, ch = idx & 15, n = idx >> 4; const float* sp = tile + (ch * 8) * 257 + n;
        u32x4 o; o.x = pk2(sp[0], sp[257]); o.y = pk2(sp[2 * 257], sp[3 * 257]); o.z = pk2(sp[4 * 257], sp[5 * 257]); o.w = pk2(sp[6 * 257], sp[7 * 257]);
        *(u32x4*)(WT + (size_t)(d0 + n) * K + k0 + 8 * ch) = o; }
}
DEV void convert_weights(const Ctx& c, int l, int wi, int nw, int part) {
    const Params& p = *c.p; unsigned char* wb = c.ws + (l == 0 ? WS_W : WS_W1); float* wre = (float*)(c.ws + WS_WRE + (size_t)l * 131072);
    const int it_lo = (part == 1) ? CV_SPLIT : 0, it_hi = (part == 0) ? CV_SPLIT : CV_NITEMS;
    const int gtid_ = wi * 512 + c.tid, nt_ = nw * 512;
    for (int it = it_lo + wi; it < it_hi; it += nw) {
        int r = it;
        if (r < CV_IN) { tr_wg_item(c, p.in[I_WIN + c.z] + (size_t)l * 1024 * 4896, 4896, 1024, (r / 20) * 128, (r % 20) * 256, 1, (bf16_t*)(wb + W_IN), nullptr); continue; } r -= CV_IN;
        if (r < CV_UQ) { tr_wg_item(c, p.in[I_WUQ + c.z] + (size_t)l * 256 * 768, 768, 256, (r / 3) * 128, (r % 3) * 256, 0, (bf16_t*)(wb + W_UQ), p.in[I_QNG + c.z] + l * 256); continue; } r -= CV_UQ;
        if (r < CV_UKV) { tr_wg_item(c, p.in[I_WUKV + c.z] + (size_t)l * 256 * 1024, 1024, 256, (r / 4) * 128, (r % 4) * 256, 0, (bf16_t*)(wb + W_UKV), p.in[I_KVNG + c.z] + l * 256); continue; } r -= CV_UKV;
        if (r < CV_BR) { tr_wg_item(c, p.in[I_WBA + c.z] + (size_t)l * 512 * 1024, 1024, 512, (r / 4) * 128, (r % 4) * 256, 0, (bf16_t*)(wb + W_BA), nullptr); continue; } r -= CV_BR;
        if (r < CV_BR) { tr_wg_item(c, p.in[I_WBB + c.z] + (size_t)l * 512 * 1024, 1024, 512, (r / 4) * 128, (r % 4) * 256, 0, (bf16_t*)(wb + W_BB), nullptr); continue; } r -= CV_BR;
        if (r < CV_OUT) { tr_wg_item(c, p.in[I_WOUT + c.z] + (size_t)l * 1024 * 1024, 1024, 1024, (r / 4) * 128, (r % 4) * 256, 0, (bf16_t*)(wb + W_OUT), nullptr); continue; } r -= CV_OUT;
        if (r < CV_GU) { const int e = r / 16, q = r % 16; tr_wg_item(c, p.in[I_WGU + c.z] + ((size_t)l * NEXP + e) * 1024 * 512, 512, 1024, (q / 2) * 128, (q % 2) * 256, 2, (bf16_t*)(wb + W_GU) + (size_t)e * 512 * 1024, nullptr); continue; } r -= CV_GU;
        { const int e = r / 8, q = r % 8; tr_wg_item(c, p.in[I_WDN + c.z] + ((size_t)l * NEXP + e) * 256 * 1024, 1024, 256, (q / 4) * 128, (q % 4) * 256, 0, (bf16_t*)(wb + W_DN) + (size_t)e * 1024 * 256, nullptr); }
    }
    __syncthreads();
    if (part == 1) return;
    for (int i = gtid_; i < 1024 * 32; i += nt_) { const int u8 = i & 7, j16 = (i >> 3) & 15, kq = (i >> 7) & 3, half = (i >> 9) & 1, cc2 = i >> 10;
        wre[i] = p.in[I_WRE + c.z][(size_t)l * 1024 * 32 + (size_t)(32 * cc2 + 8 * kq + u8) * 32 + 16 * half + j16]; }
    const float* wp = p.in[I_WPOOL + c.z] + (size_t)l * 4 * 128 * 128; const float* ps = p.in[I_PSCALE + c.z] + l * 512; const float* wc = p.in[I_WBC + c.z] + (size_t)l * 512 * 1024;
    for (int item = gtid_; item < 64 * 1024; item += nt_) {
        const int kg = item >> 10, n = item & 1023, g = kg >> 4, i0 = (kg & 15) * 8;
        float acc[8];
#pragma unroll
        for (int i = 0; i < 8; ++i) acc[i] = 0.f;
        for (int j = 0; j < 128; ++j) { const float b = ps[128 * g + j] * wc[(size_t)(128 * g + j) * 1024 + n];
#pragma unroll
            for (int i = 0; i < 8; ++i) acc[i] += wp[(size_t)(g * 128 + i0 + i) * 128 + j] * b; }
        *(u32x4*)((bf16_t*)(wb + W_BC) + (size_t)n * 512 + kg * 8) = pack8(acc);
    }
}

struct RowRaw { f32x4 x[4]; u32x2 h[4], y0[4], y1[4]; };
DEV void rows_fetch(const Ctx& c, int l, int r, RowRaw& q) {
    if (l == 0) { const float* src = (r < RX) ? c.p->in[I_X + c.z] + (size_t)r * DM : c.p->in[I_CTX + c.z] + (size_t)(r - RX) * DM;
#pragma unroll
        for (int j = 0; j < 4; ++j) q.x[j] = *(const f32x4*)(src + 4 * c.lane + 256 * j);
    } else { const bf16_t* H = (const bf16_t*)(c.ws + WS_H) + (size_t)r * DM; const bf16_t* Y = (const bf16_t*)(c.ws + WS_YTOK) + (size_t)r * 2048;
#pragma unroll
        for (int j = 0; j < 4; ++j) { const int col = 4 * c.lane + 256 * j; q.h[j] = *(const u32x2*)(H + col); q.y0[j] = *(const u32x2*)(Y + col); q.y1[j] = *(const u32x2*)(Y + 1024 + col); } }
}
struct RowPar { f32x4 gm[4], sh[4], sc[4], g2[4]; int mb; };
DEV void rows_finish(const Ctx& c, int l, bool final_, int r, const RowRaw& q, RowPar& P) {
    const int mb = mod_idx(r);
    if (mb != P.mb) { P.mb = mb;
#pragma unroll
        for (int j = 0; j < 4; ++j) { const int col = 4 * c.lane + 256 * j;
            if (l > 0) P.g2[j] = *(const f32x4*)(modp(c.ws, l - 1, mb, 5) + col);
            if (!final_) { P.sh[j] = *(const f32x4*)(modp(c.ws, l, mb, 0) + col); const f32x4 t = *(const f32x4*)(modp(c.ws, l, mb, 1) + col); P.sc[j] = P.gm[j] * (1.f + t); } } }
    f32x4 v[4];
#pragma unroll
    for (int j = 0; j < 4; ++j) {
        if (l == 0) v[j] = q.x[j];
        else { f32x4 o; const u32x2 hb = q.h[j], y0 = q.y0[j], y1 = q.y1[j]; const f32x4 g = P.g2[j];
            o.x = __uint_as_float(hb.x << 16) + g.x * (__uint_as_float(y0.x << 16) + __uint_as_float(y1.x << 16));
            o.y = __uint_as_float(hb.x & 0xffff0000u) + g.y * (__uint_as_float(y0.x & 0xffff0000u) + __uint_as_float(y1.x & 0xffff0000u));
            o.z = __uint_as_float(hb.y << 16) + g.z * (__uint_as_float(y0.y << 16) + __uint_as_float(y1.y << 16));
            o.w = __uint_as_float(hb.y & 0xffff0000u) + g.w * (__uint_as_float(y0.y & 0xffff0000u) + __uint_as_float(y1.y & 0xffff0000u));
            v[j] = o;
            if (!final_) { u32x2 w; w.x = pk2(o.x, o.y); w.y = pk2(o.z, o.w); *(u32x2*)((bf16_t*)(c.ws + WS_H) + (size_t)r * DM + 4 * c.lane + 256 * j) = w; } } }
    float s = 0.f;
#pragma unroll
    for (int j = 0; j < 4; ++j) s += (v[j].x * v[j].x + v[j].y * v[j].y) + (v[j].z * v[j].z + v[j].w * v[j].w);
    const float rstd = rsqrtf(wave_sum(s) * (1.f / DM) + EPS);
    if (final_) { float* o = (float*)c.dout + (size_t)r * DM;
#pragma unroll
        for (int j = 0; j < 4; ++j) *(f32x4*)(o + 4 * c.lane + 256 * j) = v[j] * rstd * P.gm[j];
    } else { bf16_t* xn = (bf16_t*)(c.ws + WS_XN) + (size_t)r * DM;
#pragma unroll
        for (int j = 0; j < 4; ++j) { const f32x4 t = v[j] * rstd * P.sc[j] + P.sh[j]; u32x2 w; w.x = pk2(t.x, t.y); w.y = pk2(t.z, t.w); *(u32x2*)(xn + 4 * c.lane + 256 * j) = w; } }
}
DEV void phase_rows(const Ctx& c, int l, bool final_) {
    const int nrows = final_ ? RX : R;
    const int r_lo = (int)(((long)c.gw * nrows) / c.NGW), r_hi = (int)(((long)(c.gw + 1) * nrows) / c.NGW);
    RowPar P; P.mb = -1;
    { const float* g = final_ ? c.p->in[I_FING + c.z] : c.p->in[I_GMIX + c.z] + l * DM;
#pragma unroll
      for (int j = 0; j < 4; ++j) P.gm[j] = *(const f32x4*)(g + 4 * c.lane + 256 * j); }
    if (r_lo >= r_hi) return;
    RowRaw A, B;
    rows_fetch(c, l, r_lo, A);
#pragma unroll 1
    for (int r = r_lo; r < r_hi; r += 2) {
        if (r + 1 < r_hi) rows_fetch(c, l, r + 1, B);
        rows_finish(c, l, final_, r, A, P);
        if (r + 1 < r_hi) { if (r + 2 < r_hi) rows_fetch(c, l, r + 2, A); rows_finish(c, l, final_, r + 1, B, P); }
    }
}

template <int RAD> DEV void pool_item(const Ctx& c, int g, int row) {
    const int col = g * 128 + ((int)threadIdx.x & 15) * 8;
    int base, t, L;
    if (row < RX) { base = row & ~(SEQ - 1); t = row & (SEQ - 1); L = SEQ; } else { base = RX + ((row - RX) & ~(LC - 1)); t = (row - RX) & (LC - 1); L = LC; }
    const bf16_t* U = (const bf16_t*)(c.ws + WS_U);
    u32x4 w[2 * RAD + 1];
#pragma unroll
    for (int d = -RAD; d <= RAD; ++d) { int j = t + d; j = j < 0 ? 0 : j; j = j > L - 1 ? L - 1 : j; w[d + RAD] = *(const u32x4*)(U + (size_t)(base + j) * 512 + col); }
    float s[8];
#pragma unroll
    for (int i = 0; i < 8; ++i) s[i] = 0.f;
#pragma unroll
    for (int d = -RAD; d <= RAD; ++d) { const int j = t + d; float tv[8]; unpack8(w[d + RAD], tv); const float ok = (j >= 0 && j < L) ? 1.f : 0.f;
#pragma unroll
        for (int i = 0; i < 8; ++i) s[i] += ok * tv[i]; }
    float me[8]; unpack8(w[RAD], me);
    int lo = t - RAD, hi = t + RAD + 1; if (lo < 0) lo = 0; if (hi > L) hi = L;
    const float invn = 1.f / (float)(hi - lo);
#pragma unroll
    for (int i = 0; i < 8; ++i) s[i] = s[i] * invn - me[i];
    *(u32x4*)((bf16_t*)(c.ws + WS_POOL) + (size_t)row * 512 + col) = pack8(s);
}
DEV void phase_pool(const Ctx& c, int nrows) {
    const int nq = nrows / 4;
    const int tid_ = threadIdx.x, gw_ = (int)blockIdx.x * 8 + (tid_ >> 6);
    for (int it = gw_; it < 4 * nq; it += c.NGW) {
        const int g = it / nq, row = (it - g * nq) * 4 + ((tid_ & 63) >> 4);
        if (g == 0) pool_item<1>(c, 0, row); else if (g == 1) pool_item<2>(c, 1, row); else if (g == 2) pool_item<4>(c, 2, row); else pool_item<8>(c, 3, row);
    }
}

namespace fa {
using bf16x8 = __attribute__((ext_vector_type(8))) short;
using s16x4 = __attribute__((ext_vector_type(4))) short;
using f32x16 = __attribute__((ext_vector_type(16))) float;
#define FA_SBAR() __builtin_amdgcn_sched_barrier(0)
constexpr float THR = 8.f;
DEV int crow(int r, int hi) { return (r & 3) + 8 * (r >> 2) + 4 * hi; }
typedef __bf16 bf16x2_t __attribute__((ext_vector_type(2))); typedef float f32x2_t __attribute__((ext_vector_type(2)));
DEV unsigned cvtpk(float lo, float hi) { const f32x2_t v = {lo, hi}; const bf16x2_t b = __builtin_convertvector(v, bf16x2_t); return __builtin_bit_cast(unsigned, b); }
DEV int v_st(int k, int col) { const int kk = (k & ~0xC) | ((k & 4) << 1) | ((k & 8) >> 1); return ((kk >> 3) * 2 + (col >> 5)) * 512 + ((kk & 7) * 32 + (col & 31)) * 2; }
DEV int v_rd_base(int lane) { return ((lane & 3) << 3) | (((lane >> 2) & 3) << 6) | (((lane >> 4) & 1) << 5) | (((lane >> 5) & 1) << 8); }
constexpr int v_rd_off(int d0, int ks, int half) { return d0 * 512 + ks * 2048 + half * 1024; }
template <int OFF> DEV s16x4 tr_read(int vb) { s16x4 r; asm volatile("ds_read_b64_tr_b16 %0, %1 offset:%2" : "=&v"(r) : "v"(vb), "i"(OFF) : "memory"); return r; }
template <int D0> DEV void pv_one(f32x16& od, int vb, bf16x8 pa0, bf16x8 pa1, bf16x8 pa2, bf16x8 pa3) {
    const s16x4 l0 = tr_read<v_rd_off(D0, 0, 0)>(vb), h0 = tr_read<v_rd_off(D0, 0, 1)>(vb), l1 = tr_read<v_rd_off(D0, 1, 0)>(vb), h1 = tr_read<v_rd_off(D0, 1, 1)>(vb);
    const s16x4 l2 = tr_read<v_rd_off(D0, 2, 0)>(vb), h2 = tr_read<v_rd_off(D0, 2, 1)>(vb), l3 = tr_read<v_rd_off(D0, 3, 0)>(vb), h3 = tr_read<v_rd_off(D0, 3, 1)>(vb);
    asm volatile("s_waitcnt lgkmcnt(0)" ::: "memory"); FA_SBAR();
#define FA_PK(L, H) (bf16x8){L[0], L[1], L[2], L[3], H[0], H[1], H[2], H[3]}
    od = __builtin_amdgcn_mfma_f32_32x32x16_bf16(pa0, FA_PK(l0, h0), od, 0, 0, 0);
    od = __builtin_amdgcn_mfma_f32_32x32x16_bf16(pa1, FA_PK(l1, h1), od, 0, 0, 0);
    od = __builtin_amdgcn_mfma_f32_32x32x16_bf16(pa2, FA_PK(l2, h2), od, 0, 0, 0);
    od = __builtin_amdgcn_mfma_f32_32x32x16_bf16(pa3, FA_PK(l3, h3), od, 0, 0, 0);
#undef FA_PK
}
DEV float max3f(float a, float b, float c) { float r; asm volatile("v_max3_f32 %0, %1, %2, %3" : "=v"(r) : "v"(a), "v"(b), "v"(c)); return r; }
DEV float max2f(float a, float b) { float r; asm volatile("v_max_f32_e32 %0, %1, %2" : "=v"(r) : "v"(a), "v"(b)); return r; }
DEV float halfmax32(const f32x16& p0, const f32x16& p1) {
    float a = __builtin_fmaxf(__builtin_fmaxf(p0[0], p0[1]), p1[0]), b = __builtin_fmaxf(__builtin_fmaxf(p0[2], p0[3]), p1[1]); a = __builtin_fmaxf(__builtin_fmaxf(a, p1[2]), p1[3]);
#pragma unroll
    for (int r = 4; r < 16; r += 4) { a = __builtin_fmaxf(__builtin_fmaxf(a, p0[r]), p0[r + 1]); b = __builtin_fmaxf(__builtin_fmaxf(b, p0[r + 2]), p0[r + 3]);
        a = __builtin_fmaxf(__builtin_fmaxf(a, p1[r]), p1[r + 1]); b = __builtin_fmaxf(__builtin_fmaxf(b, p1[r + 2]), p1[r + 3]); }
    return __builtin_fmaxf(a, b);
}
DEV float mergehalves_max(float m) { auto rr = __builtin_amdgcn_permlane32_swap(__float_as_uint(m), __float_as_uint(m), false, false); return __builtin_fmaxf(__uint_as_float(rr[0]), __uint_as_float(rr[1])); }
template <bool FIRST>
DEV void partialSM(f32x16& p0, f32x16& p1, float& m_reg, f32x16& negm, float& alpha) {
    const float hm = halfmax32(p0, p1);
    alpha = 1.f;
    if (FIRST || __builtin_expect(__any(hm > THR), 0)) {
        const float pm = mergehalves_max(hm);
        const float dl = FIRST ? pm : __builtin_fmaxf(pm, 0.f); m_reg += dl;
#pragma unroll
        for (int r = 0; r < 16; ++r) { p0[r] -= dl; p1[r] -= dl; }
#pragma unroll
        for (int r = 0; r < 16; ++r) negm[r] = -m_reg;
        asm volatile("" : "+v"(negm));
        if (!FIRST) alpha = __builtin_amdgcn_exp2f(-dl);
    }
#pragma unroll
    for (int r = 0; r < 16; ++r) p0[r] = __builtin_amdgcn_exp2f(p0[r]);
}
DEV void finishSM(f32x16& p0, f32x16& p1, float alpha, float& l_reg, bf16x8& pa0, bf16x8& pa1, bf16x8& pa2, bf16x8& pa3) {
#pragma unroll
    for (int r = 0; r < 16; ++r) p1[r] = __builtin_amdgcn_exp2f(p1[r]);
    float ps = p0[0] + p0[1];
#pragma unroll
    for (int r = 2; r < 16; ++r) ps += p0[r];
#pragma unroll
    for (int r = 0; r < 16; ++r) ps += p1[r];
    asm volatile("" : "+v"(ps));
    l_reg = l_reg * alpha + ps;
#define FA_PK4(P, BASE, OUT) do { unsigned a0 = cvtpk(P[BASE + 0], P[BASE + 1]), a1 = cvtpk(P[BASE + 2], P[BASE + 3]); \
    unsigned b0 = cvtpk(P[BASE + 4], P[BASE + 5]), b1 = cvtpk(P[BASE + 6], P[BASE + 7]); \
    u32x4 w = {a0, a1, b0, b1}; OUT = *reinterpret_cast<bf16x8*>(&w); } while (0)
    FA_PK4(p0, 0, pa0); FA_PK4(p0, 8, pa1); FA_PK4(p1, 0, pa2); FA_PK4(p1, 8, pa3);
#undef FA_PK4
}
DEV void glds16(const void* gsrc, unsigned lds_dst) { unsigned keep;
    asm volatile("s_mov_b32 %0, m0\n\ts_mov_b32 m0, %2\n\ts_nop 0\n\tglobal_load_lds_dwordx4 %1, off\n\ts_mov_b32 m0, %0" : "=&s"(keep) : "v"(gsrc), "s"(lds_dst) : "memory"); }
DEV void glds16x3(const void* g0, unsigned d0, const void* g1, unsigned d1, const void* g2, unsigned d2) { unsigned keep;
    asm volatile("s_mov_b32 %0, m0\n\ts_mov_b32 m0, %4\n\ts_nop 0\n\tglobal_load_lds_dwordx4 %1, off\n\ts_mov_b32 m0, %5\n\ts_nop 0\n\tglobal_load_lds_dwordx4 %2, off\n\t"
                 "s_mov_b32 m0, %6\n\ts_nop 0\n\tglobal_load_lds_dwordx4 %3, off\n\ts_mov_b32 m0, %0" : "=&s"(keep) : "v"(g0), "v"(g1), "v"(g2), "s"(d0), "s"(d1), "s"(d2) : "memory"); }
#define FA_WAIT_BAR(N) asm volatile("s_waitcnt vmcnt(" #N ") lgkmcnt(0)\n\ts_barrier" ::: "memory")
constexpr int NSLOT = 4, SHM_V = 8192, SHM_KMAX = 16384, OFF_K = 0, OFF_V = NSLOT * SHM_KMAX, OFF_WS = OFF_V + 8 * SHM_V;
struct Src {
    const bf16_t* Q; int ldq;
    bf16_t* O;
    const bf16_t* K; int ldk;
    const bf16_t* KR;
    const bf16_t* V; int ldv;
    int NT;
    int ctx_row0;
    int x_row0;
    int kloc0;
    int q0;
    float sink_l2;
};
template <int DQ, bool WIN>
DEV void attn_unit(const Src& s, unsigned char* lds) {
    constexpr int ND = DQ / 16, KROWB = (DQ == 96) ? 256 : 128, SHM_K = 64 * KROWB, NKP = (DQ == 96) ? 2 : 1;
    constexpr int NSL = WIN ? 8 : NSLOT;
    int tid_ = threadIdx.x; asm volatile("" : "+v"(tid_));
    const int tid = tid_, wid = __builtin_amdgcn_readfirstlane(tid >> 6), lane = tid & 63, r32 = lane & 31, hi = lane >> 5;
    unsigned char* V_lds = lds + OFF_V; unsigned char* K_lds = lds + OFF_K;
    const unsigned lds0 = (unsigned)(uintptr_t)lds;
    float* wsf = (float*)(lds + OFF_WS) + wid * 64; float* li_l = wsf; float* al_l = wsf + 32;
    float m_reg = 0.f, l_reg = 0.f; f32x16 o[2]; f32x16 negm; bf16x8 qr[ND];
    { float z_; asm volatile("v_mov_b32 %0, 0" : "=v"(z_));
#pragma unroll
      for (int r = 0; r < 16; ++r) { o[0][r] = z_; o[1][r] = z_; negm[r] = z_; } asm volatile("" : "+v"(negm)); }
    int krow_[NKP]; const char* kbase_[NKP]; unsigned kldb_[NKP];
#pragma unroll
    for (int pc = 0; pc < NKP; ++pc) {
        const int pk = NKP * wid + pc, row = (DQ == 96) ? (4 * pk + (lane >> 4)) : (8 * pk + (lane >> 3)), cs = (DQ == 96) ? (lane & 15) : (lane & 7), lc = cs ^ (row & 7);
        krow_[pc] = row;
        if (DQ == 96 && lc >= 8 && lc < 12) { kbase_[pc] = (const char*)s.KR + (lc - 8) * 16; kldb_[pc] = 64u; }
        else { kbase_[pc] = (const char*)s.K + ((lc < 8) ? lc : 0) * 16; kldb_[pc] = (unsigned)s.ldk * 2u; }
    }
    int vkey_; const char* vbase_;
    { const int st = 2 * wid + (lane >> 5), kk = (st >> 1) * 8 + ((lane & 31) >> 2), col = (st & 1) * 32 + (lane & 3) * 8;
        vkey_ = kk; vbase_ = (const char*)s.V + col * 2; }
    const unsigned vldb_ = (unsigned)s.ldv * 2u;
#define FA_KEYROW(t, i) (((t) < 4) ? (s.ctx_row0 + (t) * 64 + (i)) : (s.x_row0 + (WIN ? min(max(s.kloc0 + ((t) - 4) * 64 + (i), 0), SEQ - 1) : (((t) - 4) * 64 + (i)))))
#define FA_DMA(t) do { const int sl_ = (t) & (NSL - 1); \
        _Pragma("unroll") for (int pc = 0; pc < NKP; ++pc) { const unsigned kr_ = (unsigned)FA_KEYROW((t), krow_[pc]); \
            glds16(kbase_[pc] + (size_t)kr_ * kldb_[pc], (unsigned)__builtin_amdgcn_readfirstlane(lds0 + OFF_K + sl_ * SHM_K + (NKP * wid + pc) * 1024)); } \
        { const unsigned vr_ = (unsigned)FA_KEYROW((t), vkey_); glds16(vbase_ + (size_t)vr_ * vldb_, (unsigned)__builtin_amdgcn_readfirstlane(lds0 + OFF_V + sl_ * SHM_V + wid * 1024)); } } while (0)
    const char* pk0_ = nullptr; const char* pk1_ = nullptr; const char* pv_ = nullptr; unsigned kdst0_ = 0, vdst0_ = 0;
    if (!WIN) { pk0_ = kbase_[0] + (size_t)(unsigned)(s.ctx_row0 + 192 + krow_[0]) * kldb_[0]; pk1_ = kbase_[NKP - 1] + (size_t)(unsigned)(s.ctx_row0 + 192 + krow_[NKP - 1]) * kldb_[NKP - 1];
        pv_ = vbase_ + (size_t)(unsigned)(s.ctx_row0 + 192 + vkey_) * vldb_;
        kdst0_ = (unsigned)__builtin_amdgcn_readfirstlane(lds0 + OFF_K + (NKP * wid) * 1024); vdst0_ = (unsigned)__builtin_amdgcn_readfirstlane(lds0 + OFF_V + wid * 1024); }
#define FA_DMAF(t) do { const unsigned kd_ = kdst0_ + (unsigned)((t) & (NSL - 1)) * SHM_K, vd_ = vdst0_ + (unsigned)((t) & (NSL - 1)) * SHM_V; \
        glds16x3(pk0_, kd_, pk1_, kd_ + 1024u, pv_, vd_); \
        pk0_ += (size_t)(64u * kldb_[0]); pk1_ += (size_t)(64u * kldb_[NKP - 1]); pv_ += (size_t)(64u * vldb_); \
        if ((t) == 3) { asm volatile("" ::: "memory");              \
            const long jr_ = (long)s.x_row0 - (long)(s.ctx_row0 + 256); pk0_ += jr_ * (long)kldb_[0]; pk1_ += jr_ * (long)kldb_[NKP - 1]; pv_ += jr_ * (long)vldb_; } } while (0)
#define FA_WAITN(tiles_left) do { if ((tiles_left) >= 2) { if (NKP == 2) FA_WAIT_BAR(6); else FA_WAIT_BAR(4); } else if ((tiles_left) == 1) { if (NKP == 2) FA_WAIT_BAR(3); else FA_WAIT_BAR(2); } else FA_WAIT_BAR(0); } while (0)
#define FA_RESC(a) do { if (__any((a) < 1.f)) { if (hi == 0) al_l[r32] = (a); asm volatile("s_waitcnt lgkmcnt(0)" ::: "memory"); \
        _Pragma("unroll") for (int r = 0; r < 16; ++r) { const float f_ = al_l[crow(r, hi)]; o[0][r] *= f_; o[1][r] *= f_; } } } while (0)
#define FA_KRD(d0_, A_, B_) do { const int cb = (((d0_) & 3) * 16 + hi * 8) * 2;     \
            A_ = *reinterpret_cast<const bf16x8*>(Ks + r32 * KROWB + (cb ^ ((r32 & 7) << 4)) + ((d0_) >> 2) * 128); \
            B_ = *reinterpret_cast<const bf16x8*>(Ks + (32 + r32) * KROWB + (cb ^ ((r32 & 7) << 4)) + ((d0_) >> 2) * 128); } while (0)
#define FA_QKT(p0, p1, t) do { const unsigned char* Ks = K_lds + ((t) & (NSL - 1)) * SHM_K; p0 = negm; p1 = negm; bf16x8 ka_, kb_, kc_, kd_; \
        FA_KRD(0, ka_, kb_); \
        _Pragma("unroll") for (int d0 = 0; d0 < ND; d0 += 2) { \
            FA_KRD(d0 + 1, kc_, kd_); asm volatile("" ::: "memory"); \
            p0 = __builtin_amdgcn_mfma_f32_32x32x16_bf16(ka_, qr[d0], p0, 0, 0, 0); \
            p1 = __builtin_amdgcn_mfma_f32_32x32x16_bf16(kb_, qr[d0], p1, 0, 0, 0); \
            if (d0 + 2 < ND) { FA_KRD(d0 + 2, ka_, kb_); asm volatile("" ::: "memory"); } \
            p0 = __builtin_amdgcn_mfma_f32_32x32x16_bf16(kc_, qr[d0 + 1], p0, 0, 0, 0); \
            p1 = __builtin_amdgcn_mfma_f32_32x32x16_bf16(kd_, qr[d0 + 1], p1, 0, 0, 0); } \
        if (WIN) { const int kb = s.kloc0 + ((t) - 4) * 64, dk_ = kb - (s.q0 + wid * 32);     \
            if ((t) >= 4 && !(dk_ >= -97 && dk_ <= 65 && kb >= 0 && kb + 63 < SEQ)) { const int qp = s.q0 + wid * 32 + r32; \
            const int lo_ = max(qp - 128, 0), hi_ = min(qp + 128, SEQ - 1); const unsigned span_ = (unsigned)(hi_ - lo_); const int kbl_ = kb + 4 * hi - lo_;     \
            _Pragma("unroll") for (int r = 0; r < 16; ++r) { const int c_ = (r & 3) + 8 * (r >> 2); \
                if ((unsigned)(kbl_ + c_) > span_) p0[r] = -INFINITY; \
                if ((unsigned)(kbl_ + c_ + 32) > span_) p1[r] = -INFINITY; } } } } while (0)
#define FA_PV(t) do { const int vb_ = (int)(uintptr_t)V_lds + ((t) & (NSL - 1)) * SHM_V + v_rd_base(lane); pv_one<0>(o[0], vb_, pa0, pa1, pa2, pa3); pv_one<1>(o[1], vb_, pa0, pa1, pa2, pa3); } while (0)
#define FA_VU(u, Y0, Y1) do { if ((u) < 8) { Y1[2 * ((u) & 7)] = __builtin_amdgcn_exp2f(Y1[2 * ((u) & 7)]); Y1[2 * ((u) & 7) + 1] = __builtin_amdgcn_exp2f(Y1[2 * ((u) & 7) + 1]); \
            if ((u) == 0) ps_ = Y0[0] + Y0[1]; else { ps_ += Y0[2 * ((u) & 7)]; ps_ += Y0[2 * ((u) & 7) + 1]; } wq_[((u) >> 2) & 3][(u) & 3] = cvtpk(Y0[2 * ((u) & 7)], Y0[2 * ((u) & 7) + 1]); } \
        else { ps_ += Y1[2 * ((u) & 7)]; ps_ += Y1[2 * ((u) & 7) + 1]; wq_[((u) >> 2) & 3][(u) & 3] = cvtpk(Y1[2 * ((u) & 7)], Y1[2 * ((u) & 7) + 1]); } } while (0)
#define FA_GAP(g, Y0, Y1) do { if (ND == 6) { if ((g) < 8) FA_VU((g), Y0, Y1); else { FA_VU(2 * (g) - 8, Y0, Y1); FA_VU(2 * (g) - 7, Y0, Y1); } } \
        else { FA_VU((g), Y0, Y1); FA_VU(8 + (g), Y0, Y1); } asm volatile("" : "+v"(ps_)); FA_SBAR(); } while (0)
#define FA_SEG1(X0, X1, Y0, Y1, alY, t, DOD) do { const unsigned char* Ks = K_lds + ((t) & (NSL - 1)) * SHM_K; bf16x8 ka_, kb_, kc_, kd_; float ps_ = 0.f; u32x4 wq_[4]; \
        FA_KRD(0, ka_, kb_); FA_KRD(1, kc_, kd_); FA_SBAR(); \
        if (WIN) { if ((DOD) && (t) + 2 < NT) FA_DMA((t) + 2); } else if (DOD) FA_DMAF((t) + 2); \
        FA_RESC(alY); FA_SBAR(); \
          \
        _Pragma("unroll") for (int d0 = 0; d0 < ND; d0 += 2) { \
            if (d0 == 0) { X1 = __builtin_amdgcn_mfma_f32_32x32x16_bf16(kb_, qr[0], negm, 0, 0, 0); FA_GAP(0, Y0, Y1); X0 = __builtin_amdgcn_mfma_f32_32x32x16_bf16(ka_, qr[0], negm, 0, 0, 0); FA_GAP(1, Y0, Y1); } \
            else { X1 = __builtin_amdgcn_mfma_f32_32x32x16_bf16(kb_, qr[d0], X1, 0, 0, 0); FA_GAP(2 * d0, Y0, Y1); X0 = __builtin_amdgcn_mfma_f32_32x32x16_bf16(ka_, qr[d0], X0, 0, 0, 0); FA_GAP(2 * d0 + 1, Y0, Y1); } \
            if (d0 + 2 < ND) { FA_KRD(d0 + 2, ka_, kb_); } \
            X1 = __builtin_amdgcn_mfma_f32_32x32x16_bf16(kd_, qr[d0 + 1], X1, 0, 0, 0); FA_GAP(2 * d0 + 2, Y0, Y1); X0 = __builtin_amdgcn_mfma_f32_32x32x16_bf16(kc_, qr[d0 + 1], X0, 0, 0, 0); FA_GAP(2 * d0 + 3, Y0, Y1); \
            if (d0 + 3 < ND) { FA_KRD(d0 + 3, kc_, kd_); } } \
        l_reg = l_reg * (alY) + ps_; \
        pa0 = *reinterpret_cast<bf16x8*>(&wq_[0]); pa1 = *reinterpret_cast<bf16x8*>(&wq_[1]); pa2 = *reinterpret_cast<bf16x8*>(&wq_[2]); pa3 = *reinterpret_cast<bf16x8*>(&wq_[3]); \
        if (WIN) { const int kb = s.kloc0 + ((t) - 4) * 64, dk_ = kb - (s.q0 + wid * 32); \
            if ((t) >= 4 && !(dk_ >= -97 && dk_ <= 65 && kb >= 0 && kb + 63 < SEQ)) { const int qp = s.q0 + wid * 32 + r32; \
            const int lo_ = max(qp - 128, 0), hi_ = min(qp + 128, SEQ - 1); const unsigned span_ = (unsigned)(hi_ - lo_); const int kbl_ = kb + 4 * hi - lo_; \
            _Pragma("unroll") for (int r = 0; r < 16; ++r) { const int c_ = (r & 3) + 8 * (r >> 2); \
                if ((unsigned)(kbl_ + c_) > span_) X0[r] = -INFINITY; \
                if ((unsigned)(kbl_ + c_ + 32) > span_) X1[r] = -INFINITY; } } } } while (0)
#define FA_PKV(L, H) (bf16x8){L[0], L[1], L[2], L[3], H[0], H[1], H[2], H[3]}
#define FA_EXP4(X, b) do { X[(b)] = __builtin_amdgcn_exp2f(X[(b)]); X[(b) + 1] = __builtin_amdgcn_exp2f(X[(b) + 1]); X[(b) + 2] = __builtin_amdgcn_exp2f(X[(b) + 2]); X[(b) + 3] = __builtin_amdgcn_exp2f(X[(b) + 3]); } while (0)
#define FA_SEG2(X0, X1, alX, tp) do { const int vb_ = (int)(uintptr_t)V_lds + ((tp) & (NSL - 1)) * SHM_V + v_rd_base(lane); \
        const s16x4 l0 = tr_read<v_rd_off(0, 0, 0)>(vb_), h0 = tr_read<v_rd_off(0, 0, 1)>(vb_), l1 = tr_read<v_rd_off(0, 1, 0)>(vb_), h1 = tr_read<v_rd_off(0, 1, 1)>(vb_); \
        const s16x4 l2 = tr_read<v_rd_off(0, 2, 0)>(vb_), h2 = tr_read<v_rd_off(0, 2, 1)>(vb_), l3 = tr_read<v_rd_off(0, 3, 0)>(vb_), h3 = tr_read<v_rd_off(0, 3, 1)>(vb_); \
          \
          \
        float a_ = max3f(X1[0], X1[1], X1[2]), c_ = max3f(X1[7], X1[8], X1[9]), b_, d_; a_ = max3f(a_, X1[3], X1[4]); c_ = max3f(c_, X1[10], X1[11]); \
        asm volatile("s_waitcnt lgkmcnt(0)" ::: "memory"); FA_SBAR(); \
        o[0] = __builtin_amdgcn_mfma_f32_32x32x16_bf16(pa0, FA_PKV(l0, h0), o[0], 0, 0, 0); \
        const s16x4 m0_ = tr_read<v_rd_off(1, 0, 0)>(vb_), n0_ = tr_read<v_rd_off(1, 0, 1)>(vb_); a_ = max3f(a_, X1[5], X1[6]); c_ = max3f(c_, X1[12], X1[13]); b_ = max3f(X0[0], X0[1], X0[2]); FA_SBAR(); \
        o[0] = __builtin_amdgcn_mfma_f32_32x32x16_bf16(pa1, FA_PKV(l1, h1), o[0], 0, 0, 0); \
        const s16x4 m1_ = tr_read<v_rd_off(1, 1, 0)>(vb_), n1_ = tr_read<v_rd_off(1, 1, 1)>(vb_); d_ = max3f(X0[7], X0[8], X0[9]); b_ = max3f(b_, X0[3], X0[4]); d_ = max3f(d_, X0[10], X0[11]); FA_SBAR(); \
        o[0] = __builtin_amdgcn_mfma_f32_32x32x16_bf16(pa2, FA_PKV(l2, h2), o[0], 0, 0, 0); \
        const s16x4 m2_ = tr_read<v_rd_off(1, 2, 0)>(vb_), n2_ = tr_read<v_rd_off(1, 2, 1)>(vb_); b_ = max3f(b_, X0[5], X0[6]); d_ = max3f(d_, X0[12], X0[13]); a_ = max3f(a_, c_, X1[14]); FA_SBAR(); \
        o[0] = __builtin_amdgcn_mfma_f32_32x32x16_bf16(pa3, FA_PKV(l3, h3), o[0], 0, 0, 0); \
        const s16x4 m3_ = tr_read<v_rd_off(1, 3, 0)>(vb_), n3_ = tr_read<v_rd_off(1, 3, 1)>(vb_); b_ = max3f(b_, d_, X0[14]); a_ = max3f(a_, X1[15], X0[15]); const float hm_ = max2f(a_, b_); FA_SBAR(); \
        alX = 1.f; \
        if (__builtin_expect(__any(hm_ > THR), 0)) { const float pm_ = mergehalves_max(hm_); const float dl_ = __builtin_fmaxf(pm_, 0.f); m_reg += dl_; \
            _Pragma("unroll") for (int r = 0; r < 16; ++r) { X0[r] -= dl_; X1[r] -= dl_; } \
            _Pragma("unroll") for (int r = 0; r < 16; ++r) negm[r] = -m_reg; \
            asm volatile("" : "+v"(negm)); alX = __builtin_amdgcn_exp2f(-dl_); } \
        asm volatile("s_waitcnt lgkmcnt(0)" ::: "memory"); FA_SBAR(); \
        o[1] = __builtin_amdgcn_mfma_f32_32x32x16_bf16(pa0, FA_PKV(m0_, n0_), o[1], 0, 0, 0); FA_EXP4(X0, 0); asm volatile("" : "+v"(X0)); FA_SBAR(); \
        o[1] = __builtin_amdgcn_mfma_f32_32x32x16_bf16(pa1, FA_PKV(m1_, n1_), o[1], 0, 0, 0); FA_EXP4(X0, 4); asm volatile("" : "+v"(X0)); FA_SBAR(); \
        o[1] = __builtin_amdgcn_mfma_f32_32x32x16_bf16(pa2, FA_PKV(m2_, n2_), o[1], 0, 0, 0); FA_EXP4(X0, 8); asm volatile("" : "+v"(X0)); FA_SBAR(); \
        o[1] = __builtin_amdgcn_mfma_f32_32x32x16_bf16(pa3, FA_PKV(m3_, n3_), o[1], 0, 0, 0); FA_EXP4(X0, 12); asm volatile("" : "+v"(X0)); FA_SBAR(); } while (0)
    const int NT = s.NT;
    FA_DMA(0); FA_DMA(1); FA_DMA(2);
    const bf16_t* Qw = s.Q + (size_t)(wid * 32 + r32) * s.ldq + hi * 8;
#pragma unroll
    for (int d0 = 0; d0 < ND; ++d0) qr[d0] = *reinterpret_cast<const bf16x8*>(Qw + d0 * 16);
    f32x16 pA0, pA1, pB0, pB1; float alA, alB; bf16x8 pa0, pa1, pa2, pa3;
    FA_WAITN(2);
    FA_QKT(pA0, pA1, 0); partialSM<true>(pA0, pA1, m_reg, negm, alA);
    FA_WAITN(1);
    if (!WIN) {
    for (int j = 1; j + 1 < NT; j += 2) {
        FA_SEG1(pB0, pB1, pA0, pA1, alA, j, 1);
        FA_SEG2(pB0, pB1, alB, j - 1);
        FA_WAITN(1);
        FA_SEG1(pA0, pA1, pB0, pB1, alB, j + 1, 1);
        FA_SEG2(pA0, pA1, alA, j);
        FA_WAITN(1);
    }
    FA_SEG1(pB0, pB1, pA0, pA1, alA, NT - 1, 0);
    FA_SEG2(pB0, pB1, alB, NT - 2);
    FA_RESC(alB);
    finishSM(pB0, pB1, alB, l_reg, pa0, pa1, pa2, pa3);
    FA_PV(NT - 1);
    } else if (NT == 12) {
    const int lo_w = wid >> 1;
    FA_DMA(3); FA_DMA(4); FA_DMA(5); FA_DMA(6);
    FA_SEG1(pB0, pB1, pA0, pA1, alA, 1, 0); FA_PV(0); partialSM<false>(pB0, pB1, m_reg, negm, alB);
    FA_WAIT_BAR(8); FA_DMA(7); FA_DMA(8);
    FA_SEG1(pA0, pA1, pB0, pB1, alB, 2, 0); FA_PV(1); partialSM<false>(pA0, pA1, m_reg, negm, alA);
    FA_WAIT_BAR(10); FA_DMA(9);
    FA_SEG1(pB0, pB1, pA0, pA1, alA, 3, 0); FA_PV(2); partialSM<false>(pB0, pB1, m_reg, negm, alB);
    FA_WAIT_BAR(4); FA_DMA(10);
    FA_SEG1(pA0, pA1, pB0, pB1, alB, 4 + lo_w, 0); FA_PV(3); partialSM<false>(pA0, pA1, m_reg, negm, alA);
    FA_WAIT_BAR(4); FA_DMA(11);
    FA_SEG1(pB0, pB1, pA0, pA1, alA, 5 + lo_w, 0); FA_PV(4 + lo_w); partialSM<false>(pB0, pB1, m_reg, negm, alB);
    FA_WAIT_BAR(0);
    FA_SEG1(pA0, pA1, pB0, pB1, alB, 6 + lo_w, 0); FA_PV(5 + lo_w); partialSM<false>(pA0, pA1, m_reg, negm, alA);
    FA_SEG1(pB0, pB1, pA0, pA1, alA, 7 + lo_w, 0); FA_PV(6 + lo_w); partialSM<false>(pB0, pB1, m_reg, negm, alB);
    FA_SEG1(pA0, pA1, pB0, pB1, alB, 8 + lo_w, 0); FA_PV(7 + lo_w); partialSM<false>(pA0, pA1, m_reg, negm, alA);
    FA_RESC(alA);
    finishSM(pA0, pA1, alA, l_reg, pa0, pa1, pa2, pa3);
    FA_PV(8 + lo_w);
    } else { const int NT = 4;
    FA_SEG1(pB0, pB1, pA0, pA1, alA, 1, 1); FA_PV(0); partialSM<false>(pB0, pB1, m_reg, negm, alB);
    FA_WAITN(1);
    FA_SEG1(pA0, pA1, pB0, pB1, alB, 2, 1); FA_PV(1); partialSM<false>(pA0, pA1, m_reg, negm, alA);
    FA_WAITN(0);
    FA_SEG1(pB0, pB1, pA0, pA1, alA, 3, 1); FA_PV(2); partialSM<false>(pB0, pB1, m_reg, negm, alB);
    FA_RESC(alB);
    finishSM(pB0, pB1, alB, l_reg, pa0, pa1, pa2, pa3);
    FA_PV(3);
    }
    { auto rr = __builtin_amdgcn_permlane32_swap(__float_as_uint(l_reg), __float_as_uint(l_reg), false, false); l_reg = __uint_as_float(rr[0]) + __uint_as_float(rr[1]); }
    if (WIN) l_reg += __builtin_amdgcn_exp2f(s.sink_l2 - m_reg);
    int hi_e = hi, r32_e = r32; asm volatile("" : "+v"(hi_e), "+v"(r32_e));
    if (hi_e == 0) li_l[r32_e] = l_reg; asm volatile("s_waitcnt lgkmcnt(0)" ::: "memory");
    bf16_t* Ow = s.O + (size_t)(wid * 32) * s.ldq;
#pragma unroll
    for (int r = 0; r < 16; ++r) { const int orow = crow(r, hi_e); const float rl = __builtin_amdgcn_rcpf(li_l[orow]);
#pragma unroll
        for (int d0 = 0; d0 < 2; ++d0) Ow[(size_t)orow * s.ldq + d0 * 32 + r32_e] = (bf16_t)f2bf(o[d0][r] * rl); }
    FA_WAIT_BAR(0);
#undef FA_KEYROW
#undef FA_DMA
#undef FA_DMAF
#undef FA_WAITN
#undef FA_RESC
#undef FA_QKT
#undef FA_KRD
#undef FA_PV
#undef FA_VU
#undef FA_GAP
#undef FA_SEG1
#undef FA_SEG2
#undef FA_PKV
#undef FA_EXP4
}
}
DEV void phase_attn_fast(const Ctx& c, int l) {
    const bool last = (l == DEPTH - 1);
    const int nx = NB * 8 * 16, nc = last ? 0 : NB * 8;
    const int vcu = (c.G % 8 == 0) ? (int)(blockIdx.x % 8) * (c.G / 8) + (int)(blockIdx.x / 8) : (int)blockIdx.x;
    for (int it = vcu; it < nx + nc; it += c.G) {
        int r = it; const bool ctxq = r >= nx; if (ctxq) r -= nx;
        int b, h, qb;
        if (!ctxq) { qb = r & 15; h = (r >> 4) & 7; b = r >> 7; } else { qb = 0; h = r & 7; b = r >> 3; }
        const int qrow0 = ctxq ? (RX + b * LC) : (b * SEQ + qb * 256);
        fa::Src s; s.ctx_row0 = RX + b * LC; s.x_row0 = b * SEQ; s.q0 = qb * 256;
        s.Q = (const bf16_t*)(c.ws + WS_QB) + (size_t)qrow0 * 768 + h * 96; s.ldq = 768; s.O = (bf16_t*)(c.ws + WS_QB) + (size_t)qrow0 * 768 + h * 96;
        s.K = (const bf16_t*)(c.ws + WS_KNB) + h * 64; s.ldk = 512; s.KR = (const bf16_t*)(c.dout + DO_KR); s.V = (const bf16_t*)(c.ws + WS_VB) + h * 64; s.ldv = 512;
        s.NT = ctxq ? 4 : 68; s.kloc0 = 0; s.sink_l2 = 0.f;
        fa::attn_unit<96, false>(s, c.lds);
    }
    asm volatile("" ::: "memory");
    for (int it = (vcu + c.G - nc) % c.G; it < nx + nc; it += c.G) {
        int r = it; bool ctxq = r >= nx; if (ctxq) r = (r - nx + nc / 2) % (nc > 0 ? nc : 1);
        int b, h, qb;
        if (!ctxq) { qb = r & 15; h = (r >> 4) & 7; b = r >> 7; } else { qb = 0; h = r & 7; b = r >> 3; }
        const int qrow0 = ctxq ? (RX + b * LC) : (b * SEQ + qb * 256);
        fa::Src s; s.ctx_row0 = RX + b * LC; s.x_row0 = b * SEQ; s.q0 = qb * 256;
        const int kvh = h >> 2;
        s.Q = (const bf16_t*)(c.ws + WS_QA) + (size_t)qrow0 * 512 + h * 64; s.ldq = 512; s.O = (bf16_t*)(c.ws + WS_QA) + (size_t)qrow0 * 512 + h * 64;
        s.K = (const bf16_t*)(c.dout + DO_KA) + kvh * 64; s.ldk = 128; s.KR = nullptr; s.V = (const bf16_t*)(c.dout + DO_VA) + kvh * 64; s.ldv = 128;
        s.NT = ctxq ? 4 : 12; s.kloc0 = qb * 256 - 128; s.sink_l2 = c.p->in[I_SINK + c.z][l * 8 + h] * LOG2E;
        fa::attn_unit<64, true>(s, c.lds);
    }
    phase_pool(c, last ? RX : R);
}

typedef float f32x16 __attribute__((ext_vector_type(16)));
DEV void phase_router(const Ctx& c, int l) {
    const Params& p = *c.p; const int nrows = (l == DEPTH - 1) ? RX : R, ntask = nrows / 16;
    int* cnt = (int*)(c.ws + WS_CNT) + l * 32; int* list = (int*)(c.ws + WS_LIST); float* gate = (float*)(c.ws + WS_GATE);
    float* wrg_l = (float*)c.lds; float* gs_l = (float*)(c.lds + 16384) + c.wave * 2048; float* sh_l = gs_l + 1024; float* sc_l = (float*)(c.lds + 16384 + 65536) + c.wave * (16 * 33);
    for (int i = c.tid; i < 1024; i += 512) *(f32x4*)(wrg_l + 4 * i) = *(const f32x4*)(p.in[I_WRG + c.z] + (size_t)l * 4096 + 4 * i);
    __syncthreads();
    const int i_ = c.lane & 15, kq = c.lane >> 4;
    int* sel_l = (int*)(c.lds + 16384 + 65536 + 8 * 16 * 33 * 4); int* lrk_l = sel_l + 256; int* base_l = lrk_l + 256;
    const bool split = (nrows == R) && (c.G == 256);
    const int nt_full = split ? RX / 16 : ntask;
    float* glp_l = (float*)(c.lds + 16384 + 65536 + 8 * 16 * 33 * 4 + 2560);
    bool coop_done = false;
    for (int t = c.gw; ; t += c.NGW) {
        bool coop = false;
        if (t >= nt_full) { if (!split || coop_done) break; coop = true; coop_done = true; }
        int e1 = 0, e2 = 0; float g1v = 0.f, g2v = 0.f;
        const int row0 = coop ? (RX + 8 * (int)blockIdx.x) : t * 16, mb = mod_idx(row0), row = coop ? (row0 + (i_ & 7)) : (row0 + i_);
        const int it_lo = coop ? 2 * c.wave : 0, it_hi = coop ? 2 * c.wave + 2 : 16;
        { const float* g = p.in[I_GFFN + c.z] + l * DM; const float* sh = modp(c.ws, l, mb, 3); const float* scl = modp(c.ws, l, mb, 4);
#pragma unroll
            for (int j = 0; j < 4; ++j) { const int col = 4 * c.lane + 256 * j; const f32x4 gg = *(const f32x4*)(g + col), s1 = *(const f32x4*)(sh + col), s2 = *(const f32x4*)(scl + col);
                f32x4 a; a.x = gg.x * (1.f + s2.x); a.y = gg.y * (1.f + s2.y); a.z = gg.z * (1.f + s2.z); a.w = gg.w * (1.f + s2.w);
                *(f32x4*)(gs_l + col) = a; *(f32x4*)(sh_l + col) = s1; } }
        float rstd;
        { const float* sq = (const float*)(c.dout + DO_SSQH) + (size_t)row * 16; const f32x4 a = *(const f32x4*)sq, b = *(const f32x4*)(sq + 4), d = *(const f32x4*)(sq + 8), e = *(const f32x4*)(sq + 12);
            const float s = (((a.x + a.y) + (a.z + a.w)) + ((b.x + b.y) + (b.z + b.w))) + (((d.x + d.y) + (d.z + d.w)) + ((e.x + e.y) + (e.z + e.w)));
            rstd = rsqrtf(s * (1.f / DM) + EPS); }
        const bf16_t* hrow = (const bf16_t*)(c.ws + WS_H) + (size_t)row * DM + 8 * kq;
        bf16_t* fxrow = (bf16_t*)(c.ws + WS_FX) + (size_t)row * DM + 8 * kq;
        const float* Bp = (const float*)(c.ws + c.wre) + c.lane * 8;
        f32x4 acc0 = {0.f, 0.f, 0.f, 0.f}, acc1 = {0.f, 0.f, 0.f, 0.f}; float gl0 = 0.f, gl1 = 0.f, gl2 = 0.f, gl3 = 0.f;
        u32x4 hc[2], hn[2]; f32x4 bc[2][4], bn[2][4];
#pragma unroll
        for (int q = 0; q < 2; ++q) { hc[q] = *(const u32x4*)(hrow + 32 * (it_lo * 2 + q));
#pragma unroll
            for (int v = 0; v < 4; ++v) bc[q][v] = *(const f32x4*)(Bp + (it_lo * 2 + q) * 1024 + (v >> 1) * 512 + (v & 1) * 4); }
#pragma unroll 1
        for (int it = it_lo; it < it_hi; ++it) {
            const int nb = (it + 1 < it_hi ? it + 1 : it_hi - 1) * 2;
#pragma unroll
            for (int q = 0; q < 2; ++q) { hn[q] = *(const u32x4*)(hrow + 32 * (nb + q));
#pragma unroll
                for (int v = 0; v < 4; ++v) bn[q][v] = *(const f32x4*)(Bp + (nb + q) * 1024 + (v >> 1) * 512 + (v & 1) * 4); }
#pragma unroll
            for (int q = 0; q < 2; ++q) { const int cc2 = it * 2 + q;
                float h8[8]; unpack8(hc[q], h8);
                const f32x4 ga = *(const f32x4*)(gs_l + 32 * cc2 + 8 * kq), gb = *(const f32x4*)(gs_l + 32 * cc2 + 8 * kq + 4), sa = *(const f32x4*)(sh_l + 32 * cc2 + 8 * kq), sb = *(const f32x4*)(sh_l + 32 * cc2 + 8 * kq + 4);
                float fx[8];
#pragma unroll
                for (int u = 0; u < 4; ++u) { fx[u] = h8[u] * rstd * ga[u] + sa[u]; fx[4 + u] = h8[4 + u] * rstd * gb[u] + sb[u]; }
                u32x4 w; w.x = pk2(fx[0], fx[1]); w.y = pk2(fx[2], fx[3]); w.z = pk2(fx[4], fx[5]); w.w = pk2(fx[6], fx[7]); *(u32x4*)(fxrow + 32 * cc2) = w;
#pragma unroll
                for (int u = 0; u < 8; ++u) { acc0 = __builtin_amdgcn_mfma_f32_16x16x4f32(fx[u], bc[q][u >> 2][u & 3], acc0, 0, 0, 0); acc1 = __builtin_amdgcn_mfma_f32_16x16x4f32(fx[u], bc[q][2 + (u >> 2)][u & 3], acc1, 0, 0, 0); }
#pragma unroll
                for (int u = 0; u < 8; ++u) { const f32x4 wg = *(const f32x4*)(wrg_l + (32 * cc2 + 8 * kq + u) * 4); gl0 += fx[u] * wg.x; gl1 += fx[u] * wg.y; gl2 += fx[u] * wg.z; gl3 += fx[u] * wg.w; } }
#pragma unroll
            for (int q = 0; q < 2; ++q) { hc[q] = hn[q];
#pragma unroll
                for (int v = 0; v < 4; ++v) bc[q][v] = bn[q][v]; }
        }
        gl0 += __shfl_xor(gl0, 16); gl1 += __shfl_xor(gl1, 16); gl2 += __shfl_xor(gl2, 16); gl3 += __shfl_xor(gl3, 16);
        gl0 += __shfl_xor(gl0, 32); gl1 += __shfl_xor(gl1, 32); gl2 += __shfl_xor(gl2, 32); gl3 += __shfl_xor(gl3, 32);
        { const float be0 = coop ? 0.f : p.in[I_BRE + c.z][l * 32 + i_], be1 = coop ? 0.f : p.in[I_BRE + c.z][l * 32 + 16 + i_];
#pragma unroll
            for (int r = 0; r < 4; ++r) { sc_l[(4 * kq + r) * 33 + i_] = acc0[r] + be0; sc_l[(4 * kq + r) * 33 + 16 + i_] = acc1[r] + be1; } }
        if (coop) {
            if (kq == 0) { float* gp_ = glp_l + (c.wave * 16 + i_) * 4; gp_[0] = gl0; gp_[1] = gl1; gp_[2] = gl2; gp_[3] = gl3; }
            if (c.tid < 256) sel_l[c.tid] = -1;
            __syncthreads();
            if (c.wave == 0) {
                const float* sc0 = (const float*)(c.lds + 16384 + 65536);
                float a0[4], a1[4];
#pragma unroll
                for (int r = 0; r < 4; ++r) { float x0 = p.in[I_BRE + c.z][l * 32 + i_], x1 = p.in[I_BRE + c.z][l * 32 + 16 + i_];
#pragma unroll
                    for (int w = 0; w < 8; ++w) { x0 += sc0[w * (16 * 33) + (4 * kq + r) * 33 + i_]; x1 += sc0[w * (16 * 33) + (4 * kq + r) * 33 + 16 + i_]; }
                    a0[r] = x0; a1[r] = x1; }
                float t0 = 0.f, t1 = 0.f, t2 = 0.f, t3 = 0.f;
#pragma unroll
                for (int w = 0; w < 8; ++w) { const float* gp_ = glp_l + (w * 16 + i_) * 4; t0 += gp_[0]; t1 += gp_[1]; t2 += gp_[2]; t3 += gp_[3]; }
                gl0 = t0; gl1 = t1; gl2 = t2; gl3 = t3;
                __builtin_amdgcn_s_waitcnt(0xc07f); __builtin_amdgcn_wave_barrier();
#pragma unroll
                for (int r = 0; r < 4; ++r) { sc_l[(4 * kq + r) * 33 + i_] = a0[r]; sc_l[(4 * kq + r) * 33 + 16 + i_] = a1[r]; }
            }
        }
        __builtin_amdgcn_s_waitcnt(0xc07f); __builtin_amdgcn_wave_barrier();
        const bool act = coop ? (c.wave == 0 && kq == 0 && i_ < 8) : (kq == 0);
        if (act) {
            float lg[4]; lg[0] = gl0 + p.in[I_BRG + c.z][l * 4 + 0]; lg[1] = gl1 + p.in[I_BRG + c.z][l * 4 + 1]; lg[2] = gl2 + p.in[I_BRG + c.z][l * 4 + 2]; lg[3] = gl3 + p.in[I_BRG + c.z][l * 4 + 3];
            int gsel = 0; float gm = lg[0];
#pragma unroll
            for (int j = 1; j < 4; ++j) if (lg[j] > gm) { gm = lg[j]; gsel = j; }
            float den = 0.f;
#pragma unroll
            for (int j = 0; j < 4; ++j) den += __expf(lg[j] - gm);
            const float gp = 1.f / den;
            float e[8];
#pragma unroll
            for (int i = 0; i < 8; ++i) e[i] = sc_l[i_ * 33 + gsel * 8 + i];
            int i1 = 0; float v1 = e[0];
#pragma unroll
            for (int i = 1; i < 8; ++i) if (e[i] > v1) { v1 = e[i]; i1 = i; }
            int i2 = -1; float v2 = -3.0e38f;
#pragma unroll
            for (int i = 0; i < 8; ++i) if (i != i1 && e[i] > v2) { v2 = e[i]; i2 = i; }
            const float ex = __expf(v2 - v1); const float p1 = 1.f / (1.f + ex), p2 = ex / (1.f + ex);
            e1 = gsel * 8 + i1; e2 = gsel * 8 + i2; g1v = p1 * gp; g2v = p2 * gp;
            sel_l[c.wave * 32 + 2 * i_] = e1; sel_l[c.wave * 32 + 2 * i_ + 1] = e2;
        }
        __syncthreads();
        if (c.tid < 32) { int n = 0;
#pragma unroll 1
            for (int q0 = 0; q0 < 256; q0 += 16) { int ev[16];
#pragma unroll
                for (int q = 0; q < 16; ++q) ev[q] = sel_l[q0 + q];
#pragma unroll
                for (int q = 0; q < 16; ++q) if (ev[q] == c.tid) { lrk_l[q0 + q] = n; ++n; } }
            int base = 0; if (n > 0) base = atomicAdd(cnt + c.tid, n);
            base_l[c.tid] = base; }
        __syncthreads();
        if (act) {
            const int r1 = base_l[e1] + lrk_l[c.wave * 32 + 2 * i_], r2 = base_l[e2] + lrk_l[c.wave * 32 + 2 * i_ + 1];
            list[(size_t)e1 * R + r1] = row * 2; list[(size_t)e2 * R + r2] = row * 2 + 1;
            { float* lg_ = (float*)(c.dout + DO_LGATE); lg_[(size_t)e1 * R + r1] = g1v; lg_[(size_t)e2 * R + r2] = g2v; }
            gate[row * 2] = g1v; gate[row * 2 + 1] = g2v;
        }
        __syncthreads();
    }
    __syncthreads();
}

#define BFP(off) ((const bf16_t*)(c->ws + (off)))
struct SInproj { const Ctx* c; pg8::TileOrder o; int extra;
    DEV bool next(int i, pg8::Unit& u) const { int pm, pn;
        if (!o.get(i, pm, pn)) { const long L = (long)i * o.G + o.c - o.nwg; if (L < 0 || L >= extra) return false; pm = RX / 256 + (int)L / 3; const int j = (int)L % 3; pn = (j == 0) ? C_KA / 256 : (j == 1) ? C_CKV / 256 : C_KR / 256; }
        u.A = BFP(WS_XN) + (size_t)pm * 256 * 1024; u.Bt = BFP(c->wofs + W_IN) + (size_t)pn * 256 * 1024; u.lda = 1024; u.kstepA = 128; u.row0 = pm * 256; u.col0 = pn * 256; u.aux = 0; u.keep = 0; u.gl = nullptr; u.gn = 0; return true; } };
struct EInproj { const Ctx* c;
    DEV void operator()(f32x4 (&acc)[2][2][4][2], const pg8::Unit& u, int wr, int wc, int fr, int fq) const {
        const int which = (u.col0 == C_CQ) ? 0 : (u.col0 == C_CKV) ? 1 : -1;
        const bool rope = (u.row0 < RX) && (u.col0 < C_VA || u.col0 == C_KR);
#pragma unroll
        for (int ai = 0; ai < 2; ++ai)
#pragma unroll
        for (int mh = 0; mh < 2; ++mh) {
            f32x4 tb[2][2][2];
#pragma unroll
            for (int m2 = 0; m2 < 2; ++m2)
#pragma unroll
                for (int bj = 0; bj < 2; ++bj) { tb[m2][bj][0] = (f32x4){1.f, 0.f, 1.f, 0.f}; tb[m2][bj][1] = (f32x4){1.f, 0.f, 1.f, 0.f};
                    const int col0 = u.col0 + bj * 128 + wc * 32 + 8 * fq;
                    if (rope && (u.col0 != C_KA || bj == 0) && (u.col0 != C_KR || col0 < C_END)) { const f32x4* t = inproj_tab(*c, u.row0 + ai * 128 + wr * 64 + (mh * 2 + m2) * 16 + fr, col0); tb[m2][bj][0] = t[0]; tb[m2][bj][1] = t[1]; } }
#pragma unroll
            for (int m2 = 0; m2 < 2; ++m2) { const int m = mh * 2 + m2; const int row = u.row0 + ai * 128 + wr * 64 + m * 16 + fr; float ss = 0.f;
#pragma unroll
                for (int bj = 0; bj < 2; ++bj) { const int col0 = u.col0 + bj * 128 + wc * 32 + 8 * fq;
                    float v[8]; const f32x4 x0 = acc[ai][bj][m][0], x1 = acc[ai][bj][m][1];
                    v[0] = x0[0]; v[1] = x0[1]; v[2] = x0[2]; v[3] = x0[3]; v[4] = x1[0]; v[5] = x1[1]; v[6] = x1[2]; v[7] = x1[3];
                    epi_inproj(*c, row, col0, v, tb[m2][bj]);
#pragma unroll
                    for (int i = 0; i < 8; ++i) ss += v[i] * v[i]; }
                if (which >= 0) { ss += __shfl_xor(ss, 16); ss += __shfl_xor(ss, 32);
                    if (fq == 0) ((float*)(c->ws + WS_SSQ))[(size_t)(row * 2 + which) * 4 + wc] = ss; } }
            asm volatile("" ::: "memory"); } } };
struct SUp { const Ctx* c; pg8::TileOrder o;
    DEV bool next(int i, pg8::Unit& u) const { int pm, pn; if (!o.get(i, pm, pn)) return false;
        if (pn < 3) { u.A = BFP(WS_CQ) + (size_t)pm * 256 * 256; u.Bt = BFP(c->wofs + W_UQ) + (size_t)pn * 256 * 256; u.col0 = pn * 256; u.aux = 0; }
        else { u.A = BFP(WS_CKV) + (size_t)pm * 256 * 256; u.Bt = BFP(c->wofs + W_UKV) + (size_t)(pn - 3) * 256 * 256; u.col0 = (pn - 3) * 256; u.aux = 1; }
        u.lda = 256; u.kstepA = 128; u.row0 = pm * 256; u.keep = 0; u.gl = nullptr; u.gn = 0; return true; } };
struct EUp { const Ctx* c;
    DEV void operator()(f32x4 (&acc)[2][2][4][2], const pg8::Unit& u, int wr, int wc, int fr, int fq) const {
        float rs[2][4];
#pragma unroll
        for (int ai = 0; ai < 2; ++ai)
#pragma unroll
            for (int m = 0; m < 4; ++m) { const int row = u.row0 + ai * 128 + wr * 64 + m * 16 + fr;
                const f32x4 sq = *(const f32x4*)((const float*)(c->ws + WS_SSQ) + (size_t)(row * 2 + u.aux) * 4); rs[ai][m] = rsqrtf(((sq.x + sq.y) + (sq.z + sq.w)) * (1.f / 256.f) + EPS); }
#pragma unroll
        for (int ai = 0; ai < 2; ++ai) {
#pragma unroll
            for (int m = 0; m < 4; ++m) { const int row = u.row0 + ai * 128 + wr * 64 + m * 16 + fr;
#pragma unroll
                for (int bj = 0; bj < 2; ++bj) { const int col0 = u.col0 + bj * 128 + wc * 32 + 8 * fq;
                    float v[8]; const f32x4 x0 = acc[ai][bj][m][0], x1 = acc[ai][bj][m][1];
                    v[0] = x0[0]; v[1] = x0[1]; v[2] = x0[2]; v[3] = x0[3]; v[4] = x1[0]; v[5] = x1[1]; v[6] = x1[2]; v[7] = x1[3];
                    if (u.aux == 0) epi_upq(*c, row, col0, v, rs[ai][m] * SCALE_B); else epi_upkv(*c, row, col0, v, rs[ai][m]); } }
            asm volatile("" ::: "memory"); } } };
struct SBranch { const Ctx* c; pg8::TileOrder o;
    DEV bool next(int i, pg8::Unit& u) const { int pm, pn; const int pair = i / 3, br = i - pair * 3; if (!o.get(pair, pm, pn)) return false;
        if (br == 0) { u.A = BFP(WS_QA) + (size_t)pm * 256 * 512; u.lda = 512; u.kstepA = 128; u.Bt = BFP(c->wofs + W_BA) + (size_t)pn * 256 * 512; }
        else if (br == 1) { u.A = BFP(WS_QB) + (size_t)pm * 256 * 768; u.lda = 768; u.kstepA = 192; u.Bt = BFP(c->wofs + W_BB) + (size_t)pn * 256 * 512; }
        else { u.A = BFP(WS_POOL) + (size_t)pm * 256 * 512; u.lda = 512; u.kstepA = 128; u.Bt = BFP(c->wofs + W_BC) + (size_t)pn * 256 * 512; }
        u.row0 = pm * 256; u.col0 = pn * 256; u.aux = br; u.keep = (br < 2); u.gl = nullptr; u.gn = 0; return true; } };
DEV void gates_u8(const u32x2 w, float (&g)[8]) {
    g[0] = (float)(w.x & 255u); g[1] = (float)((w.x >> 8) & 255u); g[2] = (float)((w.x >> 16) & 255u); g[3] = (float)(w.x >> 24);
    g[4] = (float)(w.y & 255u); g[5] = (float)((w.y >> 8) & 255u); g[6] = (float)((w.y >> 16) & 255u); g[7] = (float)(w.y >> 24); }
struct EBranch { const Ctx* c;
    DEV void operator()(f32x4 (&acc)[2][2][4][2], const pg8::Unit& u, int wr, int wc, int fr, int fq) const {
        const unsigned char* G = c->dout + DO_G;
#pragma unroll
        for (int ai = 0; ai < 2; ++ai) {
            u32x2 ga[4][2], gb[4][2];
#pragma unroll
            for (int m = 0; m < 4; ++m)
#pragma unroll
                for (int bj = 0; bj < 2; ++bj) { const size_t off = (size_t)(u.row0 + ai * 128 + wr * 64 + m * 16 + fr) * 3072 + (u.col0 + bj * 128 + wc * 32 + 8 * fq);
                    ga[m][bj] = *(const u32x2*)(G + off + u.aux * 1024); gb[m][bj] = ga[m][bj]; if (u.aux < 2) gb[m][bj] = *(const u32x2*)(G + off + (u.aux + 1) * 1024); }
#pragma unroll
            for (int m = 0; m < 4; ++m) { const int row = u.row0 + ai * 128 + wr * 64 + m * 16 + fr;
#pragma unroll
                for (int bj = 0; bj < 2; ++bj) { const int col0 = u.col0 + bj * 128 + wc * 32 + 8 * fq;
                    float g0[8]; gates_u8(ga[m][bj], g0);
                    if (u.aux < 2) { float g1[8]; gates_u8(gb[m][bj], g1);
#pragma unroll
                        for (int i = 0; i < 4; ++i) { acc[ai][bj][m][0][i] *= g0[i] * __builtin_amdgcn_rcpf(g1[i]); acc[ai][bj][m][1][i] *= g0[4 + i] * __builtin_amdgcn_rcpf(g1[4 + i]); }
                    } else { float y[8];
#pragma unroll
                        for (int i = 0; i < 4; ++i) { y[i] = acc[ai][bj][m][0][i] * g0[i] * (1.f / 255.f); y[4 + i] = acc[ai][bj][m][1][i] * g0[4 + i] * (1.f / 255.f); }
                        *(u32x4*)((bf16_t*)(c->ws + WS_Y) + (size_t)row * 1024 + col0) = pack8(y); } } }
            asm volatile("" ::: "memory"); } } };
struct SOut { const Ctx* c; pg8::TileOrder o;
    DEV bool next(int i, pg8::Unit& u) const { int pm, pn; if (!o.get(i, pm, pn)) return false;
        u.A = BFP(WS_Y) + (size_t)pm * 256 * 1024; u.Bt = BFP(c->wofs + W_OUT) + (size_t)pn * 256 * 1024; u.lda = 1024; u.kstepA = 128; u.row0 = pm * 256; u.col0 = pn * 256; u.aux = 0; u.keep = 0; u.gl = nullptr; u.gn = 0; return true; } };
template <int L> struct EOut { const Ctx* c;
    DEV void operator()(f32x4 (&acc)[2][2][4][2], const pg8::Unit& u, int wr, int wc, int fr, int fq) const {
        const float* basef = (u.row0 < RX ? c->p->in[I_X + c->z] + (size_t)u.row0 * DM : c->p->in[I_CTX + c->z] + (size_t)(u.row0 - RX) * DM) + u.col0;
        bf16_t* Hp = (bf16_t*)(c->ws + WS_H) + (size_t)u.row0 * DM + u.col0;
        const float* g1p = modp(c->ws, L, mod_idx(u.row0), 2) + u.col0 + wc * 32 + 8 * fq;
        f32x4 g[2][2];
#pragma unroll
        for (int bj = 0; bj < 2; ++bj) { g[bj][0] = *(const f32x4*)(g1p + bj * 128); g[bj][1] = *(const f32x4*)(g1p + bj * 128 + 4); }
        const int cl = wc * 32 + 8 * fq;
#pragma unroll
        for (int ai = 0; ai < 2; ++ai) { constexpr int mh = 0;
            u32x4 bq[4][2][2];
#pragma unroll
            for (int m2 = 0; m2 < 4; ++m2)
#pragma unroll
                for (int bj = 0; bj < 2; ++bj) { const unsigned off = (unsigned)((ai * 128 + wr * 64 + (mh * 2 + m2) * 16 + fr) * DM + cl + bj * 128);
                    if (L == 0) { bq[m2][bj][0] = *(const u32x4*)(basef + off); bq[m2][bj][1] = *(const u32x4*)(basef + off + 4); } else bq[m2][bj][0] = *(const u32x4*)(Hp + off); }
#pragma unroll
            for (int m2 = 0; m2 < 4; ++m2) { const int m = mh * 2 + m2; const int lr = ai * 128 + wr * 64 + m * 16 + fr; float ss = 0.f;
#pragma unroll
                for (int bj = 0; bj < 2; ++bj) { f32x4 b0, b1;
                    if (L == 0) { b0 = __builtin_bit_cast(f32x4, bq[m2][bj][0]); b1 = __builtin_bit_cast(f32x4, bq[m2][bj][1]); }
                    else { float t[8]; unpack8(bq[m2][bj][0], t); b0 = (f32x4){t[0], t[1], t[2], t[3]}; b1 = (f32x4){t[4], t[5], t[6], t[7]}; }
                    const f32x4 o0 = b0 + g[bj][0] * acc[ai][bj][m][0], o1 = b1 + g[bj][1] * acc[ai][bj][m][1];
                    u32x4 w; w.x = pk2(o0.x, o0.y); w.y = pk2(o0.z, o0.w); w.z = pk2(o1.x, o1.y); w.w = pk2(o1.z, o1.w);
                    *(u32x4*)(Hp + (unsigned)(lr * DM + cl + bj * 128)) = w;
                    ss += ((o0.x * o0.x + o0.y * o0.y) + (o0.z * o0.z + o0.w * o0.w)) + ((o1.x * o1.x + o1.y * o1.y) + (o1.z * o1.z + o1.w * o1.w)); }
                ss += __shfl_xor(ss, 16); ss += __shfl_xor(ss, 32);
                if (fq == 0) ((float*)(c->dout + DO_SSQH) + (size_t)u.row0 * 16 + (u.col0 >> 8) * 4)[(unsigned)(lr * 16 + wc)] = ss; }
            asm volatile("" ::: "memory"); } } };
constexpr int LDS_TT = 128 * 1024;
DEV void build_tile_table(const Ctx& c, const int* cnt) {
    int* tt = (int*)(c.lds + LDS_TT);
    for (int t = c.tid; t <= MAXTILES; t += 512) { int acc_t = 0, v = -1;
        for (int e = 0; e < NEXP; ++e) { const int nte = (cnt[e] + 255) >> 8; if (v < 0 && t < acc_t + nte) v = (e << 16) | (t - acc_t); acc_t += nte; }
        tt[t] = v; }
    __syncthreads();
}
template <int NPN> struct SMoe { const Ctx* c; const int* cnt; int G, cid;
    DEV bool next(int i, pg8::Unit& u) const {
        const int L = i * G + cid, tile = L / NPN, pn = L - tile * NPN;
        if (tile >= MAXTILES) return false;
        const int v = __builtin_amdgcn_readfirstlane(((const int*)(c->lds + LDS_TT))[tile]);
        if (v < 0) return false;
        const int e = v >> 16, j = v & 0xffff; const int ce = cnt[e];
        u.gl = (const int*)(c->ws + WS_LIST) + (size_t)e * R + j * 256; u.gn = min(256, ce - j * 256); u.keep = 0; u.aux = e; u.kstepA = 128;
        if (NPN == 2) { u.A = BFP(WS_FX); u.lda = 1024; u.Bt = BFP(c->wofs + W_GU) + ((size_t)e * 512 + pn * 256) * 1024; u.row0 = tile * 256; u.col0 = pn * 128; }
        else { u.A = BFP(WS_H1) + (size_t)tile * 256 * 256; u.lda = 256; u.Bt = BFP(c->wofs + W_DN) + ((size_t)e * 1024 + pn * 256) * 256; u.row0 = 0; u.col0 = pn * 256; }
        return true; } };
struct EMoe1 { const Ctx* c;
    DEV void operator()(f32x4 (&acc)[2][2][4][2], const pg8::Unit& u, int wr, int wc, int fr, int fq) const {
#pragma unroll
        for (int ai = 0; ai < 2; ++ai)
#pragma unroll
            for (int m = 0; m < 4; ++m) { const int slot = u.row0 + ai * 128 + wr * 64 + m * 16 + fr; const int col = u.col0 + wc * 32 + 8 * fq; float h[8];
#pragma unroll
                for (int i = 0; i < 4; ++i) { const float g0 = acc[ai][0][m][0][i], g1 = acc[ai][0][m][1][i];
                    h[i] = g0 * sigmoid_fast(g0) * acc[ai][1][m][0][i]; h[4 + i] = g1 * sigmoid_fast(g1) * acc[ai][1][m][1][i]; }
                *(u32x4*)((bf16_t*)(c->ws + WS_H1) + (size_t)slot * 256 + col) = pack8(h); } } };
struct EMoe2 { const Ctx* c;
    DEV void operator()(f32x4 (&acc)[2][2][4][2], const pg8::Unit& u, int wr, int wc, int fr, int fq) const {
        int tk[2][4]; float gt[2][4];
        const float* lgp = (const float*)(c->dout + DO_LGATE) + (u.gl - (const int*)(c->ws + WS_LIST));
#pragma unroll
        for (int ai = 0; ai < 2; ++ai)
#pragma unroll
            for (int m = 0; m < 4; ++m) { const int lr = ai * 128 + wr * 64 + m * 16 + fr; const bool ok = lr < u.gn; tk[ai][m] = ok ? u.gl[lr] : -1; gt[ai][m] = ok ? lgp[lr] : 0.f; }
#pragma unroll
        for (int ai = 0; ai < 2; ++ai)
#pragma unroll
            for (int m = 0; m < 4; ++m) { if (tk[ai][m] >= 0) {
#pragma unroll
                for (int bj = 0; bj < 2; ++bj) { const int col0 = u.col0 + bj * 128 + wc * 32 + 8 * fq; float y[8];
#pragma unroll
                    for (int i = 0; i < 4; ++i) { y[i] = acc[ai][bj][m][0][i] * gt[ai][m]; y[4 + i] = acc[ai][bj][m][1][i] * gt[ai][m]; }
                    *(u32x4*)((bf16_t*)(c->ws + WS_YTOK) + (size_t)tk[ai][m] * 1024 + col0) = pack8(y); } } } } };

#define LAS __attribute__((address_space(3)))
#define XB_TMO      128
#define XB_XCNT(j)  (256  + 64 * (j))
#define XB_XSUB(j)  (1280 + 64 * (j))
#define XB_XGEN(j)  (2304 + 64 * (j))
#define XB_TOP      3328
#define XB_TOPGEN   3392
#define XCD_BAR_WORDS 3456
#define XB_SPIN_CAP (1u << 18)
DEV unsigned xb_ld(unsigned* p)              { return __hip_atomic_load(p, __ATOMIC_RELAXED, __HIP_MEMORY_SCOPE_AGENT); }
DEV unsigned xb_add(unsigned* p, unsigned v) { return __hip_atomic_fetch_add(p, v, __ATOMIC_RELAXED, __HIP_MEMORY_SCOPE_AGENT); }
DEV unsigned xb_xcc_id() { return (unsigned)__builtin_amdgcn_s_getreg((3 << 11) | 20) & 0xFu; }
#define XB_SPIN(cond, bar) do { unsigned _sp = 0; while (cond) { __builtin_amdgcn_s_sleep(1); \
    if ((++_sp & 255u) == 0u) { if (xb_ld(&(bar)[XB_TMO])) break; if (_sp > XB_SPIN_CAP) { atomicAdd(&(bar)[XB_TMO], 1u); break; } } } } while (0)
struct XcdBarrier { unsigned* bar; unsigned x; volatile LAS unsigned* st; };
DEV XcdBarrier xcd_barrier_post(unsigned* bar, volatile LAS unsigned* st) {
    XcdBarrier b; b.bar = bar; b.x = xb_xcc_id(); b.st = st;
    if (threadIdx.x == 0) (void)xb_add(&bar[XB_XCNT(b.x)], 1u);
    return b;
}
DEV void xcd_barrier_complete(unsigned* bar, unsigned x, unsigned& nloc, unsigned& nx) {
    const unsigned G = gridDim.x * gridDim.y * gridDim.z;
    unsigned sum, cnt, mine, sp = 0u;
    for (;;) {
        sum = 0u; cnt = 0u; mine = 0u;
#pragma unroll
        for (unsigned j = 0; j < 16; ++j) { const unsigned c = xb_ld(&bar[XB_XCNT(j)]); sum += c; cnt += (c > 0u) ? 1u : 0u; mine = (j == x) ? c : mine; }
        if (sum == G) break;
        __builtin_amdgcn_s_sleep(1);
        if ((++sp & 255u) == 0u) { if (xb_ld(&bar[XB_TMO])) break; if (sp > XB_SPIN_CAP) { atomicAdd(&bar[XB_TMO], 1u); break; } }
    }
    nloc = mine > 0u ? mine : 1u; nx = cnt > 0u ? cnt : 1u;
}
DEV void xcd_barrier(const XcdBarrier& b) {
    asm volatile("s_waitcnt vmcnt(0)" ::: "memory");
    __syncthreads();
    if (threadIdx.x == 0) {
        unsigned* bar = b.bar;
        __builtin_amdgcn_s_waitcnt(0);
        unsigned nloc = b.st[0], nx = b.st[1];
        if (nloc == 0u) { xcd_barrier_complete(bar, b.x, nloc, nx); b.st[0] = nloc; b.st[1] = nx; }
        const unsigned old = xb_add(&bar[XB_XSUB(b.x)], 1u);
        const unsigned gen = old / nloc;
        if (old + 1u == (gen + 1u) * nloc) {
            __builtin_amdgcn_fence(__ATOMIC_RELEASE, "agent");
            asm volatile("s_waitcnt vmcnt(0)" ::: "memory");
            const unsigned og = xb_add(&bar[XB_TOP], 1u);
            const unsigned tg = og / nx;
            if (og + 1u == (tg + 1u) * nx) xb_add(&bar[XB_TOPGEN], 1u);
            else XB_SPIN(xb_ld(&bar[XB_TOPGEN]) == tg, bar);
            __builtin_amdgcn_fence(__ATOMIC_ACQUIRE, "agent");
            xb_add(&bar[XB_XGEN(b.x)], 1u);
            asm volatile("s_waitcnt vmcnt(0)" ::: "memory");
        } else {
            XB_SPIN(xb_ld(&bar[XB_XGEN(b.x)]) == gen, bar);
            __builtin_amdgcn_fence(__ATOMIC_ACQUIRE, "agent");
            asm volatile("s_waitcnt vmcnt(0)" ::: "memory");
        }
    }
    __syncthreads();
}

constexpr int STEPS = 9, NPROG = 1 + DEPTH * STEPS + 1;
constexpr int LDS_BARST = 131 * 1024;
DEV Ctx make_ctx(const Params& p, unsigned char* lds) {
    typedef __attribute__((address_space(1))) unsigned char gchar_t;
    gchar_t* ws_ = (gchar_t*)p.ws; gchar_t* do_ = (gchar_t*)p.out; int z_ = 0; int tid_ = threadIdx.x;
    asm volatile("" : "+s"(ws_), "+s"(do_), "+s"(z_)); asm volatile("" : "+v"(tid_));
    Ctx c; c.p = &p; c.z = z_; c.dummy = 0; c.wofs = WS_W; c.wre = WS_WRE; c.ws = (unsigned char*)ws_; c.dout = (unsigned char*)do_; c.lds = lds;
    c.tid = tid_; c.lane = c.tid & 63; c.wave = __builtin_amdgcn_readfirstlane(c.tid >> 6); c.G = gridDim.x + z_; c.gw = blockIdx.x * 8 + c.wave; c.NGW = c.G * 8; c.gtid = blockIdx.x * 512 + c.tid; c.NT = c.G * 512;
    return c;
}
DEV void tail_convert(const Ctx& c, int l, int part) {
    if (l != 0 || DEPTH < 2) return;
    const int nbusy = (R / 256) * 4 - 2 * c.G;
    if (nbusy <= 0 || nbusy >= c.G || 3 * c.G < (R / 256) * 4) { if (part == 1) { convert_weights(c, 1, (int)blockIdx.x, c.G, 0); convert_weights(c, 1, (int)blockIdx.x, c.G, 1); } return; }
    if ((int)blockIdx.x >= nbusy) convert_weights(c, 1, (int)blockIdx.x - nbusy, c.G - nbusy, part);
}
DEV void run_step(const Ctx& c0, int l, int s) {
    Ctx c = c0; c.wofs = (l == 0) ? WS_W : WS_W1; c.wre = WS_WRE + (size_t)l * 131072;
    const bool last = (l == DEPTH - 1); const int nrows = last ? RX : R;
    PG8_LAS unsigned char* L3 = (PG8_LAS unsigned char*)c.lds;
    if (s == 0) phase_rows(c, l, false);
    else if (s == 1) { SInproj S{&c}; S.extra = last ? (RC / 256) * 3 : 0; S.o.init((last ? RX : R) / 256, NIN / 256, c.G, (int)blockIdx.x); EInproj E{&c}; pg8::gemm_phase<EInproj, SInproj, false>(L3, 1024, S, E); }
    else if (s == 2) { SUp S{&c}; S.o.init(R / 256, 7, c.G, (int)blockIdx.x); EUp E{&c}; pg8::gemm_phase<EUp, SUp, false>(L3, 256, S, E); }
    else if (s == 3) phase_attn_fast(c, l);
    else if (s == 4) { SBranch S{&c}; S.o.init(nrows / 256, 4, c.G, (int)blockIdx.x); EBranch E{&c}; pg8::gemm_phase<EBranch, SBranch, false>(L3, 512, S, E); tail_convert(c, l, 0); }
    else if (s == 5) { SOut S{&c}; S.o.init(nrows / 256, 4, c.G, (int)blockIdx.x); if (l == 0) { EOut<0> E{&c}; pg8::gemm_phase<EOut<0>, SOut, false>(L3, 1024, S, E); } else { EOut<1> E{&c}; pg8::gemm_phase<EOut<1>, SOut, false>(L3, 1024, S, E); } tail_convert(c, l, 1); }
    else if (s == 6) phase_router(c, l);
    else if (s == 7) { const int* cnt = (const int*)(c.ws + WS_CNT) + l * 32; build_tile_table(c, cnt); SMoe<2> S{&c, cnt, c.G, (int)blockIdx.x}; EMoe1 E{&c}; pg8::gemm_phase<EMoe1, SMoe<2>, true>(L3, 1024, S, E); }
    else { const int* cnt = (const int*)(c.ws + WS_CNT) + l * 32; build_tile_table(c, cnt); SMoe<4> S{&c, cnt, c.G, (int)blockIdx.x}; EMoe2 E{&c}; pg8::gemm_phase<EMoe2, SMoe<4>, false>(L3, 256, S, E); }
}
#define SEAM(k) do { if ((k) + 1 < p.ph_hi) { XcdBarrier xb_; xb_.bar = (unsigned*)(p.ws + WS_BAR); xb_.x = xb_xcc_id(); xb_.st = (volatile LAS unsigned*)((LAS unsigned char*)lds + LDS_BARST); xcd_barrier(xb_); } } while (0)
#define STEP(k, body) do { if (p.ph_lo <= (k) && (k) < p.ph_hi) { { const Ctx c = make_ctx(p, lds); body; } SEAM(k); } } while (0)
template <int L> DEV void layer_steps(const Params& p, cg::grid_group& grid, unsigned char* lds) {
    STEP(1 + L * STEPS + 0, run_step(c, L, 0));
    STEP(1 + L * STEPS + 1, run_step(c, L, 1));
    STEP(1 + L * STEPS + 2, run_step(c, L, 2));
    STEP(1 + L * STEPS + 3, run_step(c, L, 3));
    STEP(1 + L * STEPS + 4, run_step(c, L, 4));
    STEP(1 + L * STEPS + 5, run_step(c, L, 5));
    STEP(1 + L * STEPS + 6, run_step(c, L, 6));
    STEP(1 + L * STEPS + 7, run_step(c, L, 7));
    STEP(1 + L * STEPS + 8, run_step(c, L, 8));
}
__global__ void __launch_bounds__(512, 2) mk(Params p) {
    extern __shared__ __attribute__((aligned(16))) unsigned char lds[];
    cg::grid_group grid = cg::this_grid();
    volatile LAS unsigned* st = (volatile LAS unsigned*)((LAS unsigned char*)lds + LDS_BARST);
    if (threadIdx.x < 2) st[threadIdx.x] = 0u;
    __syncthreads();
    (void)xcd_barrier_post((unsigned*)(p.ws + WS_BAR), st);
    grid.sync();
    STEP(0, { phase_p0(c); convert_weights(c, 0, (int)blockIdx.x, c.G, -1); });
    layer_steps<0>(p, grid, lds);
    layer_steps<1>(p, grid, lds);
    STEP(NPROG - 1, phase_rows(c, DEPTH, true));
}

constexpr int LDS_BYTES = 132 * 1024;
extern "C" void kernel_launch(void* const* d_in, const int* in_sizes, int n_in, void* d_out, int out_size, void* d_ws, size_t ws_size, hipStream_t stream) {
    static int grid = 0;
    if (grid == 0) {
        if (n_in != 27 || out_size != RX * DM || ws_size < WS_NEED) { fprintf(stderr, "kernel_launch: unexpected shapes n_in %d out %d ws %zu\n", n_in, out_size, ws_size); grid = -1; return; }
        int dev = 0, cus = 0, per_cu = 0;
        hipGetDevice(&dev); hipDeviceGetAttribute(&cus, hipDeviceAttributeMultiprocessorCount, dev);
        hipFuncSetAttribute((const void*)mk, hipFuncAttributeMaxDynamicSharedMemorySize, LDS_BYTES);
        hipOccupancyMaxActiveBlocksPerMultiprocessor(&per_cu, (const void*)mk, 512, LDS_BYTES);
        if (per_cu < 1) { fprintf(stderr, "kernel_launch: occupancy query says %d\n", per_cu); grid = -1; return; }
        grid = cus;
    }
    if (grid < 0) return;
    Params p{};
    for (int i = 0; i < 27; ++i) p.in[i] = (const float*)d_in[i];
    p.out = (float*)d_out; p.ws = (unsigned char*)d_ws;
    if (hipMemsetAsync((unsigned char*)d_ws + WS_BAR, 0, XCD_BAR_WORDS * 4, stream) != hipSuccess) { fprintf(stderr, "kernel_launch: memset failed\n"); return; }
    p.ph_lo = 0; p.ph_hi = NPROG;
    void* args[] = {&p};
    hipError_t e = hipLaunchCooperativeKernel((const void*)mk, dim3(grid), dim3(512), args, LDS_BYTES, stream);
    if (e != hipSuccess) fprintf(stderr, "cooperative launch failed: %s\n", hipGetErrorString(e));
}
```
